# Optimizing an MI355X kernel written in HIP

```python
import math
import jax, jax.numpy as jnp
from jax import lax
import numpy as np

D_MODEL = 1024
BATCH = 8
SEQ = 4096
DEPTH = 4

GRID_W = 64
NUM_MIXERS = 2
HEAD_DIM = 64
MIX_WIDTH = D_MODEL
A_HEADS = MIX_WIDTH // HEAD_DIM
A_WIN_ROWS = 8
A_WIN_COLS = 16
B_Q_HEADS = MIX_WIDTH // HEAD_DIM
B_KV_HEADS = 4
B_QBLK = 128
ROPE_THETA = 10000.0
ROPE_SECTION = HEAD_DIM // 2
PLE_DIM = 256
NORM_EPS = 1e-6

kernel_name = "hybrid_natten_gqa_axial_rope_encoder"


def rms_norm(x, g):
    xf = x.astype(jnp.float32)
    y = xf * lax.rsqrt(jnp.mean(xf * xf, axis=-1, keepdims=True) + NORM_EPS)
    return (y * g.astype(jnp.float32)).astype(x.dtype)


def _na_indices(rows):
    win_r = min(A_WIN_ROWS, rows)
    win_c = A_WIN_COLS
    r = np.arange(rows)
    c = np.arange(GRID_W)
    rs = np.clip(r - win_r // 2, 0, rows - win_r)
    cs = np.clip(c - win_c // 2, 0, GRID_W - win_c)
    key_r = rs[:, None] + np.arange(win_r)[None, :]
    key_c = cs[:, None] + np.arange(win_c)[None, :]
    idx = key_r[:, None, :, None] * GRID_W + key_c[None, :, None, :]
    idx = idx.reshape(rows, GRID_W, win_r * win_c).astype(np.int32)
    dr = (key_r - r[:, None] + (A_WIN_ROWS - 1)).astype(np.int32)
    dc = (key_c - c[:, None] + (A_WIN_COLS - 1)).astype(np.int32)
    return idx, dr, dc


def mixer_a(h, w_in, rpb, w_out):
    b, s, _ = h.shape
    rows = s // GRID_W
    idx_np, dr, dc = _na_indices(rows)
    nk = idx_np.shape[-1]
    proj = h @ w_in
    q, k, v, gate = jnp.split(proj, 4, axis=-1)
    to_heads = lambda t: t.reshape(b, s, A_HEADS, HEAD_DIM).transpose(0, 2, 1, 3)
    q, k, v = to_heads(q), to_heads(k), to_heads(v)
    bias = rpb[:, dr[:, None, :, None], dc[None, :, None, :]]
    bias = bias.reshape(A_HEADS, rows, GRID_W, nk).transpose(1, 0, 2, 3)
    q_blk = q.reshape(b, A_HEADS, rows, GRID_W, HEAD_DIM).transpose(2, 0, 1, 3, 4)
    idx = jnp.asarray(idx_np)
    scale = 1.0 / math.sqrt(HEAD_DIM)

    def row_block(args):
        qb, ib, bb = args
        flat = ib.reshape(-1)
        kg = jnp.take(k, flat, axis=2).reshape(b, A_HEADS, GRID_W, nk, HEAD_DIM)
        vg = jnp.take(v, flat, axis=2).reshape(b, A_HEADS, GRID_W, nk, HEAD_DIM)
        sc = jnp.einsum('bhqd,bhqnd->bhqn', qb, kg).astype(jnp.float32) * scale
        sc = sc + bb.astype(jnp.float32)[None]
        pr = jax.nn.softmax(sc, axis=-1).astype(vg.dtype)
        return jnp.einsum('bhqn,bhqnd->bhqd', pr, vg)

    o = lax.map(row_block, (q_blk, idx, bias))
    o = o.transpose(1, 0, 3, 2, 4).reshape(b, s, MIX_WIDTH)
    return (o * jax.nn.silu(gate)) @ w_out


def _axial_rope(seq):
    t = jnp.arange(seq)
    row = (t // GRID_W).astype(jnp.float32)
    col = (t % GRID_W).astype(jnp.float32)
    n_freq = ROPE_SECTION // 2
    inv = jnp.power(ROPE_THETA, -jnp.arange(n_freq, dtype=jnp.float32) * 2.0 / ROPE_SECTION)
    ang_r = row[:, None] * inv[None, :]
    ang_c = col[:, None] * inv[None, :]
    return jnp.cos(ang_r), jnp.sin(ang_r), jnp.cos(ang_c), jnp.sin(ang_c)


def _rotate(x, cos, sin):
    x1, x2 = jnp.split(x, 2, axis=-1)
    return jnp.concatenate([x1 * cos - x2 * sin, x2 * cos + x1 * sin], axis=-1)


def _apply_axial_rope(x, tabs):
    cos_r, sin_r, cos_c, sin_c = tabs
    xf = x.astype(jnp.float32)
    xr = _rotate(xf[..., :ROPE_SECTION], cos_r, sin_r)
    xc = _rotate(xf[..., ROPE_SECTION:], cos_c, sin_c)
    return jnp.concatenate([xr, xc], axis=-1).astype(x.dtype)


def mixer_b(h, w_in, q_norm_g, k_norm_g, w_out):
    b, s, _ = h.shape
    group = B_Q_HEADS // B_KV_HEADS
    kv_w = B_KV_HEADS * HEAD_DIM
    proj = h @ w_in
    q, k, v, gate = jnp.split(proj, [MIX_WIDTH, MIX_WIDTH + kv_w, MIX_WIDTH + 2 * kv_w], axis=-1)
    q = rms_norm(q.reshape(b, s, B_Q_HEADS, HEAD_DIM), q_norm_g).transpose(0, 2, 1, 3)
    k = rms_norm(k.reshape(b, s, B_KV_HEADS, HEAD_DIM), k_norm_g).transpose(0, 2, 1, 3)
    v = v.reshape(b, s, B_KV_HEADS, HEAD_DIM).transpose(0, 2, 1, 3)
    tabs = _axial_rope(s)
    q = _apply_axial_rope(q, tabs)
    k = _apply_axial_rope(k, tabs)
    nb = s // B_QBLK
    q_blk = q.reshape(b, B_KV_HEADS, group, nb, B_QBLK, HEAD_DIM).transpose(3, 0, 1, 2, 4, 5)
    scale = 1.0 / math.sqrt(HEAD_DIM)

    def q_block(qb):
        sc = jnp.einsum('bkgqd,bksd->bkgqs', qb, k).astype(jnp.float32) * scale
        pr = jax.nn.softmax(sc, axis=-1).astype(v.dtype)
        return jnp.einsum('bkgqs,bksd->bkgqd', pr, v)

    o = lax.map(q_block, q_blk)
    o = o.transpose(1, 0, 4, 2, 3, 5).reshape(b, s, MIX_WIDTH)
    return (o * jax.nn.silu(gate)) @ w_out


def setup_inputs(seed: int = 0) -> dict:
    key = jax.random.key(seed)
    ks = jax.random.split(key, 16)
    n_a = (DEPTH + NUM_MIXERS - 1) // NUM_MIXERS
    n_b = DEPTH // NUM_MIXERS
    kv_w = B_KV_HEADS * HEAD_DIM
    b_in_w = 2 * MIX_WIDTH + 2 * kv_w
    nrm = lambda k, shape, fan: jax.random.normal(k, shape, jnp.float32) * (fan ** -0.5)
    gain = lambda k, shape: 1.0 + 0.05 * jax.random.normal(k, shape, jnp.float32)
    return {
        "x": jax.random.normal(ks[0], (BATCH, SEQ, D_MODEL), jnp.float32),
        "p": jax.random.normal(ks[1], (DEPTH, BATCH, SEQ, PLE_DIM), jnp.float32),
        "norm_g": gain(ks[2], (DEPTH, D_MODEL)),
        "a_w_in": nrm(ks[3], (n_a, D_MODEL, 4 * MIX_WIDTH), D_MODEL),
        "a_rpb": 0.1 * jax.random.normal(ks[4], (n_a, A_HEADS, 2 * A_WIN_ROWS - 1, 2 * A_WIN_COLS - 1), jnp.float32),
        "a_w_out": nrm(ks[5], (n_a, MIX_WIDTH, D_MODEL), MIX_WIDTH),
        "b_w_in": nrm(ks[6], (n_b, D_MODEL, b_in_w), D_MODEL),
        "b_q_norm": gain(ks[7], (n_b, HEAD_DIM)),
        "b_k_norm": gain(ks[8], (n_b, HEAD_DIM)),
        "b_w_out": nrm(ks[9], (n_b, MIX_WIDTH, D_MODEL), MIX_WIDTH),
        "ple_norm_g": gain(ks[10], (DEPTH, D_MODEL)),
        "ple_w_gate": nrm(ks[11], (DEPTH, D_MODEL, D_MODEL), D_MODEL),
        "ple_w_proj": nrm(ks[12], (DEPTH, PLE_DIM, D_MODEL), PLE_DIM),
        "final_norm_g": gain(ks[13], (D_MODEL,)),
    }


def reference(x, p, norm_g, a_w_in, a_rpb, a_w_out, b_w_in, b_q_norm, b_k_norm,
              b_w_out, ple_norm_g, ple_w_gate, ple_w_proj, final_norm_g):
    for i in range(DEPTH):
        h = rms_norm(x, norm_g[i])
        j = i // NUM_MIXERS
        if i % NUM_MIXERS == 0:
            y = mixer_a(h, a_w_in[j], a_rpb[j], a_w_out[j])
        else:
            y = mixer_b(h, b_w_in[j], b_q_norm[j], b_k_norm[j], b_w_out[j])
        x = x + y
        g = jax.nn.sigmoid(rms_norm(x, ple_norm_g[i]) @ ple_w_gate[i])
        x = x + g * (p[i] @ ple_w_proj[i])
    return rms_norm(x, final_norm_g)
```

```cpp
#include <hip/hip_runtime.h>
#include <hip/hip_cooperative_groups.h>
#include <hip/hip_bf16.h>
#include <cstdio>
#include <cstdint>
#include <cmath>
namespace pg8 {
#define PG8_LAS __attribute__((address_space(3)))
typedef unsigned short bf16_t;
typedef short bf16x8 __attribute__((ext_vector_type(8)));
typedef float f32x4 __attribute__((ext_vector_type(4)));
typedef unsigned u32x4 __attribute__((ext_vector_type(4)));
constexpr int BM = 256, BK = 64, HALF = 128, HTB = HALF * BK * 2  , STAGE_BYTES = 8 * HTB, NXCD = 8, WGM = 8;

__host__ __device__ __forceinline__ int lds_byte(int r, int c) { const int st = (r >> 4) * 2 + (c >> 5), rr = r & 15, cc = c & 31, ob = rr * 64 + cc * 2; return st * 1024 + (ob ^ (((ob >> 9) & 1) << 5)); }
__host__ __device__ __forceinline__ void stage_rc(int b, int& R, int& C) { const int st = b / 1024, sb = b % 1024, swz = sb ^ (((sb >> 9) & 1) << 5); R = (st >> 1) * 16 + swz / 64; C = (st & 1) * 32 + (swz % 64) / 2; }
__host__ __device__ __forceinline__ int perm32(int rho) { const int n = rho >> 4, i = rho & 15; return 8 * (i >> 2) + 4 * n + (i & 3); }

struct Unit { int pm, pn; };
struct Gemm { const bf16_t* A; const bf16_t* Bt; int M, N, K, lda, ldb; };

struct StaticOrder {
    int nM, nN, nwg, G, c;
    __host__ __device__ void init(int M, int N, int G_, int c_) { nM = M / BM; nN = N / BM; nwg = nM * nN; G = G_; c = c_; }
    __host__ __device__ bool next(int i, Unit& u) const {
        const long L = (long)i * G + c; if (L >= nwg) return false;
        int wgid = (int)L; { const int q = nwg / NXCD, r = nwg % NXCD, xcd = wgid % NXCD, off = wgid / NXCD; wgid = (xcd < r ? xcd * (q + 1) : r * (q + 1) + (xcd - r) * q) + off; }
        const int nig = WGM * nN, gid = wgid / nig, fm = gid * WGM, gsz = (nM - fm) < WGM ? (nM - fm) : WGM;
        u.pm = fm + ((wgid % nig) % gsz); u.pn = (wgid % nig) / gsz; return true;
    }
    __device__ __forceinline__ void a_ready(const Unit&) const {}
    __device__ __forceinline__ void done(const Unit&) const {}
};

__device__ __forceinline__ unsigned cvt_pk_bf16(float lo, float hi) { unsigned r; asm volatile("v_cvt_pk_bf16_f32 %0, %1, %2" : "=v"(r) : "v"(lo), "v"(hi)); return r; }
typedef unsigned u32x2 __attribute__((ext_vector_type(2)));
constexpr float NORM_EPS = 1e-6f;
constexpr int DMODEL = 1024, NSLOT_SS = 16;
__device__ __forceinline__ float row_rstd(const float* ssp, int row, int fq) {
    const f32x4 v = *(const f32x4*)(ssp + (size_t)row * NSLOT_SS + 4 * fq);
    float s = (v[0] + v[1]) + (v[2] + v[3]);
    s += __shfl_xor(s, 16); s += __shfl_xor(s, 32);
    return rsqrtf(s * (1.0f / DMODEL) + NORM_EPS);
}
__device__ __forceinline__ float sigmoid_f(float x) { return __builtin_amdgcn_rcpf(1.f + __builtin_amdgcn_exp2f(-1.4426950408889634f * x)); }

template <int MODE, bool HT = false> struct EpiBf16S {
    static constexpr bool PERM = true, AFTER_DRAIN = false;
    bf16_t* O; int ldc; const float* ssp; int q_cols; float scale0;
    __device__ __forceinline__ void operator()(const f32x4 (&acc)[2][2][4][2], const Unit& u, int wr, int wc, int fr, int fq) const {
        asm volatile("" : "+v"(fr), "+v"(fq));
        const int row0 = u.pm * BM + wr * 64 + fr, col0 = u.pn * BM + wc * 32 + 8 * fq;
        const float sc = (MODE == 1 && u.pn * BM < q_cols) ? scale0 : 1.f;
        float cs[2][8];
        if (MODE == 2) {
            const int cj = col0 + (fr >> 3) * HALF + (fr & 7);
            float s = 0.f;
#pragma unroll
            for (int k = 0; k < 4; ++k) { const f32x4 v = *(const f32x4*)(ssp + (size_t)cj * NSLOT_SS + 4 * k); s += (v[0] + v[1]) + (v[2] + v[3]); }
            const float r = rsqrtf(s * (1.0f / DMODEL) + NORM_EPS);
            const int lane = fq * 16 + fr;
#pragma unroll
            for (int bj = 0; bj < 2; ++bj)
#pragma unroll
                for (int e = 0; e < 8; ++e) cs[bj][e] = __shfl(r, (lane & 48) + bj * 8 + e);
        }
#pragma unroll
        for (int ai = 0; ai < 2; ++ai)
#pragma unroll
            for (int m = 0; m < 4; ++m) { const int row = row0 + ai * HALF + m * 16; bf16_t* rowp = O + (size_t)row * ldc + col0;
                float rs = sc; if (MODE == 1) rs *= row_rstd(ssp, row, fq);
#pragma unroll
                for (int bj = 0; bj < 2; ++bj) { f32x4 v0 = acc[ai][bj][m][0], v1 = acc[ai][bj][m][1];
                    bf16_t* dst = rowp + bj * HALF;
                    if (HT && MODE == 1) { const int c = col0 + bj * HALF; dst = O + ((size_t)(c >> 10) << 25) + ((size_t)(((row >> 12) << 4) + ((c >> 6) & 15)) * 4096 + (row & 4095)) * 64 + (c & 63); }
                    if (HT && MODE == 2) { const int c = col0 + bj * HALF; dst = O + ((((size_t)(((c >> 12) << 4) + (row >> 6)) * 64 + ((c >> 6) & 63)) * 64 + (row & 63)) * 64) + (c & 63); }
                    if (MODE == 2) { v0[0] *= cs[bj][0]; v0[1] *= cs[bj][1]; v0[2] *= cs[bj][2]; v0[3] *= cs[bj][3]; v1[0] *= cs[bj][4]; v1[1] *= cs[bj][5]; v1[2] *= cs[bj][6]; v1[3] *= cs[bj][7]; }
                    else if (MODE == 1) { v0 = v0 * rs; v1 = v1 * rs; }
                    u32x4 w; w.x = cvt_pk_bf16(v0[0], v0[1]); w.y = cvt_pk_bf16(v0[2], v0[3]); w.z = cvt_pk_bf16(v1[0], v1[1]); w.w = cvt_pk_bf16(v1[2], v1[3]);
                    *(u32x4*)dst = w; } }
    }
};

struct EpiQKRope {
    static constexpr bool PERM = false, AFTER_DRAIN = false;
    bf16_t* O; int ldc; const float* ssp; const float* qg; const float* kg; const float* ropec; const float* ropes; float c2;
    bf16_t* KT; bf16_t* VTt;
    __device__ __forceinline__ void operator()(const f32x4 (&acc)[2][2][4][2], const Unit& u, int wr, int wc, int fr, int fq) const {
        asm volatile("" : "+v"(fr), "+v"(fq));
        const int row0 = u.pm * BM + wr * 64 + fr, col0 = u.pn * BM + wc * 64 + 4 * fq;
        const bool qk = u.pn < 5;
        if (!qk) {
            const int colv = u.pn * BM + wc * 32 + 8 * fq;
#pragma unroll
            for (int ai = 0; ai < 2; ++ai)
#pragma unroll
                for (int m = 0; m < 4; ++m) { const int row = row0 + ai * HALF + m * 16; bf16_t* rowp = O + (size_t)row * ldc + colv;
                    const float rs = row_rstd(ssp, row, fq);
#pragma unroll
                    for (int bj = 0; bj < 2; ++bj) { const f32x4 v0 = acc[ai][bj][m][0] * rs, v1 = acc[ai][bj][m][1] * rs;
                        u32x4 w; w.x = cvt_pk_bf16(v0[0], v0[1]); w.y = cvt_pk_bf16(v0[2], v0[3]); w.z = cvt_pk_bf16(v1[0], v1[1]); w.w = cvt_pk_bf16(v1[2], v1[3]);
                        bf16_t* dst = rowp + bj * HALF;
                        if (u.pn == 5) { const int kvh = 2 * bj + (wc >> 1), s = row & 4095;
                            dst = VTt + ((((size_t)((row >> 12) * 4 + kvh) * 64 + (s >> 6)) * 2 + (wc & 1)) * 64 + (s & 63)) * 32 + 8 * fq; }
                        *(u32x4*)dst = w; } }
            return;
        }
        const float* gp = (u.pn < 4) ? qg : kg; const float osc = (u.pn < 4) ? c2 : 1.f;
#pragma unroll
        for (int ai = 0; ai < 2; ++ai)
#pragma unroll
            for (int m = 0; m < 4; ++m) { const int row = row0 + ai * HALF + m * 16; bf16_t* rowp = O + (size_t)row * ldc + col0;
                const float rs = row_rstd(ssp, row, fq);
                f32x4 v[2][2];
#pragma unroll
                for (int bj = 0; bj < 2; ++bj)
#pragma unroll
                    for (int n = 0; n < 2; ++n) v[bj][n] = acc[ai][bj][m][n] * rs;
                if (qk) {
                    const float* gp2 = gp; asm volatile("" : "+s"(gp2));
                    f32x4 gn[2][2];
#pragma unroll
                    for (int bj = 0; bj < 2; ++bj)
#pragma unroll
                        for (int n = 0; n < 2; ++n) gn[bj][n] = *(const f32x4*)(gp2 + 32 * bj + 16 * n + 4 * fq);
                    float sq = 0.f;
#pragma unroll
                    for (int bj = 0; bj < 2; ++bj)
#pragma unroll
                        for (int n = 0; n < 2; ++n) sq += (v[bj][n][0] * v[bj][n][0] + v[bj][n][1] * v[bj][n][1]) + (v[bj][n][2] * v[bj][n][2] + v[bj][n][3] * v[bj][n][3]);
                    sq += __shfl_xor(sq, 16); sq += __shfl_xor(sq, 32);
                    const float hr = rsqrtf(sq * (1.0f / 64.0f) + NORM_EPS);
                    const int t = row & 4095, prow = t >> 6, pcol = t & 63;
#pragma unroll
                    for (int bj = 0; bj < 2; ++bj) { const int pos = bj ? pcol : prow;
                        const f32x4 c = *(const f32x4*)(ropec + pos * 16 + 4 * fq), s = *(const f32x4*)(ropes + pos * 16 + 4 * fq);
                        const f32x4 x1 = v[bj][0] * hr * gn[bj][0], x2 = v[bj][1] * hr * gn[bj][1];
                        v[bj][0] = (x1 * c - x2 * s) * osc; v[bj][1] = (x2 * c + x1 * s) * osc; }
                }
#pragma unroll
                for (int bj = 0; bj < 2; ++bj) {
                    u32x2 w0, w1;
                    w0.x = cvt_pk_bf16(v[bj][0][0], v[bj][0][1]); w0.y = cvt_pk_bf16(v[bj][0][2], v[bj][0][3]);
                    w1.x = cvt_pk_bf16(v[bj][1][0], v[bj][1][1]); w1.y = cvt_pk_bf16(v[bj][1][2], v[bj][1][3]);
                    { auto r0 = __builtin_amdgcn_permlane16_swap(w0.x, w1.x, false, false); w0.x = r0[0]; w1.x = r0[1];
                      auto r1 = __builtin_amdgcn_permlane16_swap(w0.y, w1.y, false, false); w0.y = r1[0]; w1.y = r1[1]; }
                    u32x4 ww; ww.x = w0.x; ww.y = w0.y; ww.z = w1.x; ww.w = w1.y;
                    const int dd = 32 * bj + ((fq & 1) ? 16 + 4 * (fq - 1) : 4 * fq);
                    bf16_t* dst = O + (size_t)row * ldc + u.pn * BM + wc * 64 + dd;
                    if (u.pn == 4) { const int s = row & 4095;
                        dst = KT + (((((size_t)((row >> 12) * 4 + wc) * 64 + (s >> 6)) * 8 + (dd >> 3)) * 64 + (s & 63)) * 8); }
                    *(u32x4*)dst = ww; }
            }
    }
};

template <bool GATE> struct EpiResid {
    static constexpr bool PERM = true, AFTER_DRAIN = false;
    const float* xin32; const bf16_t* rin; bf16_t* rout; const bf16_t* pp; const float* ssp_in; float* ssp_out;
    __device__ __forceinline__ void operator()(const f32x4 (&acc)[2][2][4][2], const Unit& u, int wr, int wc, int fr, int fq) const {
        asm volatile("" : "+v"(fr), "+v"(fq));
        const int row0 = u.pm * BM + wr * 64 + fr, col0 = u.pn * BM + wc * 32 + 8 * fq;
#pragma unroll
        for (int ai = 0; ai < 2; ++ai)
#pragma unroll
            for (int m = 0; m < 4; ++m) { const int row = row0 + ai * HALF + m * 16; const size_t off = (size_t)row * DMODEL + col0;
                float rs = 0.f; if (GATE) rs = row_rstd(ssp_in, row, fq);
                float sq = 0.f;
#pragma unroll
                for (int bj = 0; bj < 2; ++bj) { const size_t c = off + bj * HALF;
                    f32x4 xi0, xi1;
                    if (xin32) { xi0 = __builtin_nontemporal_load((const f32x4*)(xin32 + c)); xi1 = __builtin_nontemporal_load((const f32x4*)(xin32 + c + 4)); }
                    else { const u32x4 rw = *(const u32x4*)(rin + c);
                        xi0[0] = __uint_as_float(rw.x << 16); xi0[1] = __uint_as_float(rw.x & 0xffff0000u); xi0[2] = __uint_as_float(rw.y << 16); xi0[3] = __uint_as_float(rw.y & 0xffff0000u);
                        xi1[0] = __uint_as_float(rw.z << 16); xi1[1] = __uint_as_float(rw.z & 0xffff0000u); xi1[2] = __uint_as_float(rw.w << 16); xi1[3] = __uint_as_float(rw.w & 0xffff0000u); }
                    f32x4 a0 = acc[ai][bj][m][0], a1 = acc[ai][bj][m][1];
                    if (GATE) { const u32x4 pw = *(const u32x4*)(pp + c);
                        a0[0] = sigmoid_f(a0[0] * rs) * __uint_as_float(pw.x << 16); a0[1] = sigmoid_f(a0[1] * rs) * __uint_as_float(pw.x & 0xffff0000u);
                        a0[2] = sigmoid_f(a0[2] * rs) * __uint_as_float(pw.y << 16); a0[3] = sigmoid_f(a0[3] * rs) * __uint_as_float(pw.y & 0xffff0000u);
                        a1[0] = sigmoid_f(a1[0] * rs) * __uint_as_float(pw.z << 16); a1[1] = sigmoid_f(a1[1] * rs) * __uint_as_float(pw.z & 0xffff0000u);
                        a1[2] = sigmoid_f(a1[2] * rs) * __uint_as_float(pw.w << 16); a1[3] = sigmoid_f(a1[3] * rs) * __uint_as_float(pw.w & 0xffff0000u); }
                    const f32x4 xo0 = xi0 + a0, xo1 = xi1 + a1;
                    u32x4 w; w.x = cvt_pk_bf16(xo0[0], xo0[1]); w.y = cvt_pk_bf16(xo0[2], xo0[3]); w.z = cvt_pk_bf16(xo1[0], xo1[1]); w.w = cvt_pk_bf16(xo1[2], xo1[3]);
                    *(u32x4*)(rout + c) = w;
                    sq += ((xo0[0] * xo0[0] + xo0[1] * xo0[1]) + (xo0[2] * xo0[2] + xo0[3] * xo0[3])) + ((xo1[0] * xo1[0] + xo1[1] * xo1[1]) + (xo1[2] * xo1[2] + xo1[3] * xo1[3])); }
                sq += __shfl_xor(sq, 16); sq += __shfl_xor(sq, 32);
                if (fq == 0) ssp_out[(size_t)row * NSLOT_SS + u.pn * 4 + wc] = sq;
            }
    }
};

template <class Epi, class Sched, bool ALIGN_EPI = false, bool SP2 = false>
__device__ __forceinline__ void gemm_phase(PG8_LAS unsigned char* lds, const Gemm g, const Sched& S, const Epi& E) {
    int tid_ = threadIdx.x; asm volatile("" : "+v"(tid_));
    const int tid = tid_, wid = __builtin_amdgcn_readfirstlane(tid >> 6), lane = tid & 63, wr = wid >> 2, wc = wid & 3, fr = lane & 15, fq = lane >> 4;
    int K_ = g.K; asm volatile("" : "+s"(K_)); const int K = K_, nt = K / BK;
    unsigned voffA[2], voffB[2];
#pragma unroll
    for (int i = 0; i < 2; ++i) { int R, C; stage_rc(tid * 16 + i * 8192, R, C); const int Rb = Epi::PERM ? ((R & ~31) + perm32(R & 31)) : R;
        voffA[i] = (unsigned)(R * g.lda + C) * 2u; voffB[i] = (unsigned)(Rb * g.ldb + C) * 2u; }
    const size_t kstep = (size_t)(BK * 2);
    const size_t hsA = (size_t)HALF * g.lda * 2, hsB = (size_t)HALF * g.ldb * 2;
    const size_t tsA = 2 * hsA, tsB = 2 * hsB;
    const unsigned ldsw = (unsigned)wid * 1024u;
    const int aoff = lds_byte(wr * 64 + fr, fq * 8), boff = lds_byte(wc * 32 + fr, fq * 8);
#define PG8_SA(b, h) (((b) * 2 + (h)) * HTB)
#define PG8_SB(b, h) ((4 + (b) * 2 + (h)) * HTB)
#define PG8_STAGE(bufoff, gbase, voff) do { _Pragma("unroll") for (int _i = 0; _i < 2; ++_i) \
        __builtin_amdgcn_global_load_lds((const unsigned*)((const char*)(gbase) + (voff)[_i]), (PG8_LAS unsigned*)(lds + (bufoff) + ldsw + _i * 8192), 16, 0, 0); } while (0)
#define PG8_LDA(dst, b, h) do { _Pragma("unroll") for (int m = 0; m < 4; ++m) _Pragma("unroll") for (int k = 0; k < 2; ++k) dst[m][k] = *(const PG8_LAS bf16x8*)(lds + PG8_SA(b, h) + aoff + m * 2048 + k * 1024); } while (0)
#define PG8_LDB(dst, b, h) do { _Pragma("unroll") for (int n = 0; n < 2; ++n) _Pragma("unroll") for (int k = 0; k < 2; ++k) dst[n][k] = *(const PG8_LAS bf16x8*)(lds + PG8_SB(b, h) + boff + n * 2048 + k * 1024); } while (0)
#define PG8_MMA(ai, bj, At, Bt) do { __builtin_amdgcn_s_setprio(1); _Pragma("unroll") for (int m = 0; m < 4; ++m) _Pragma("unroll") for (int n = 0; n < 2; ++n) _Pragma("unroll") for (int k = 0; k < 2; ++k) \
        acc[ai][bj][m][n] = __builtin_amdgcn_mfma_f32_16x16x32_bf16(Bt[n][k], At[m][k], acc[ai][bj][m][n], 0, 0, 0); __builtin_amdgcn_s_setprio(0); } while (0)
#define PG8_WAIT_V(n) asm volatile("s_waitcnt vmcnt(" #n ")" ::: "memory")
#define PG8_WAIT_L(n) asm volatile("s_waitcnt lgkmcnt(" #n ")" ::: "memory")
#define PG8_BAR __builtin_amdgcn_s_barrier()
#define PG8_SCHED __builtin_amdgcn_sched_barrier(0)
    Unit cur, nxt; int ui = 0;
    if (!S.next(0, cur)) return;
    f32x4 acc[2][2][4][2];
#pragma unroll
    for (int a = 0; a < 2; ++a)
#pragma unroll
        for (int b = 0; b < 2; ++b)
#pragma unroll
            for (int m = 0; m < 4; ++m)
#pragma unroll
                for (int n = 0; n < 2; ++n) acc[a][b][m][n] = (f32x4){0.f, 0.f, 0.f, 0.f};
    bf16x8 At[4][2], B0[2][2], B1[2][2];
    const char* cA = (const char*)g.A + (size_t)cur.pm * tsA; const char* cB = (const char*)g.Bt + (size_t)cur.pn * tsB;
    S.a_ready(cur);
    if constexpr (SP2) {
        PG8_STAGE(PG8_SB(0, 0), cB, voffB); PG8_STAGE(PG8_SB(0, 1), cB + hsB, voffB); PG8_STAGE(PG8_SA(0, 0), cA, voffA); PG8_STAGE(PG8_SA(0, 1), cA + hsA, voffA);
        if (wr == 1) PG8_BAR;
        PG8_WAIT_V(2); PG8_BAR;
        PG8_STAGE(PG8_SB(1, 0), cB + kstep, voffB); PG8_STAGE(PG8_SA(1, 0), cA + kstep, voffA); PG8_STAGE(PG8_SB(1, 1), cB + hsB + kstep, voffB);
        PG8_WAIT_V(6); PG8_BAR;
    } else {
        PG8_STAGE(PG8_SB(0, 0), cB, voffB); PG8_STAGE(PG8_SA(0, 0), cA, voffA); PG8_STAGE(PG8_SB(0, 1), cB + hsB, voffB); PG8_STAGE(PG8_SA(0, 1), cA + hsA, voffA);
        if (wr == 1) PG8_BAR;
        PG8_WAIT_V(4); PG8_BAR;
        PG8_STAGE(PG8_SB(1, 0), cB + kstep, voffB); PG8_STAGE(PG8_SA(1, 0), cA + kstep, voffA); PG8_STAGE(PG8_SB(1, 1), cB + hsB + kstep, voffB);
        PG8_WAIT_V(6); PG8_BAR;
    }
    for (;;) {
        const bool has_next = S.next(ui + 1, nxt);
        const char* nA = has_next ? (const char*)g.A + (size_t)nxt.pm * tsA : cA; const char* nB = has_next ? (const char*)g.Bt + (size_t)nxt.pn * tsB : cB;
        for (int t = 0; t < nt; t += 2) {
            const bool last = (t == nt - 2);
            const char* a1 = cA + (size_t)(t + 1) * kstep;
            const char* a2 = last ? nA : cA + (size_t)(t + 2) * kstep; const char* b2 = last ? nB : cB + (size_t)(t + 2) * kstep;
            const char* a3 = a2 + kstep; const char* b3 = b2 + kstep;
            if (last && has_next) S.a_ready(nxt);
            if constexpr (SP2) {
            PG8_LDB(B0, 0, 0); PG8_LDB(B1, 0, 1); PG8_SCHED; PG8_LDA(At, 0, 0); PG8_STAGE(PG8_SA(1, 1), a1 + hsA, voffA);
            PG8_WAIT_V(8); PG8_WAIT_L(0); PG8_BAR; PG8_MMA(0, 0, At, B0); PG8_MMA(0, 1, At, B1); PG8_BAR; PG8_SCHED;
            PG8_LDA(At, 0, 1); PG8_STAGE(PG8_SB(0, 0), b2, voffB); PG8_STAGE(PG8_SB(0, 1), b2 + hsB, voffB); PG8_STAGE(PG8_SA(0, 0), a2, voffA);
            PG8_WAIT_V(8); PG8_WAIT_L(0); PG8_BAR; PG8_MMA(1, 0, At, B0); PG8_MMA(1, 1, At, B1); PG8_BAR; PG8_SCHED;
            PG8_LDB(B0, 1, 0); PG8_LDB(B1, 1, 1); PG8_SCHED; PG8_LDA(At, 1, 0); PG8_STAGE(PG8_SA(0, 1), a2 + hsA, voffA);
            PG8_WAIT_V(8); PG8_WAIT_L(0); PG8_BAR; PG8_MMA(0, 0, At, B0); PG8_MMA(0, 1, At, B1); PG8_BAR; PG8_SCHED;
            PG8_LDA(At, 1, 1); PG8_STAGE(PG8_SB(1, 0), b3, voffB); PG8_STAGE(PG8_SB(1, 1), b3 + hsB, voffB); PG8_STAGE(PG8_SA(1, 0), a3, voffA);
            PG8_WAIT_V(8); PG8_WAIT_L(0); PG8_BAR; PG8_MMA(1, 0, At, B0); PG8_MMA(1, 1, At, B1); PG8_BAR; PG8_SCHED;
            } else {
            PG8_LDB(B0, 0, 0); PG8_SCHED; PG8_LDA(At, 0, 0); PG8_STAGE(PG8_SA(1, 1), a1 + hsA, voffA);
            PG8_WAIT_L(8); PG8_BAR; PG8_WAIT_L(0); PG8_MMA(0, 0, At, B0); PG8_BAR; PG8_SCHED;
            PG8_LDB(B1, 0, 1); PG8_STAGE(PG8_SB(0, 0), b2, voffB);
            PG8_BAR; PG8_WAIT_L(0); PG8_MMA(0, 1, At, B1); PG8_BAR;
            PG8_LDA(At, 0, 1); PG8_STAGE(PG8_SA(0, 0), a2, voffA);
            PG8_BAR; PG8_WAIT_L(0); PG8_MMA(1, 0, At, B0); PG8_BAR; PG8_SCHED;
            PG8_STAGE(PG8_SB(0, 1), b2 + hsB, voffB);
            PG8_WAIT_V(6); PG8_BAR; PG8_MMA(1, 1, At, B1); PG8_BAR;
            PG8_LDB(B0, 1, 0); PG8_SCHED; PG8_LDA(At, 1, 0); PG8_STAGE(PG8_SA(0, 1), a2 + hsA, voffA);
            PG8_WAIT_L(8); PG8_BAR; PG8_WAIT_L(0); PG8_MMA(0, 0, At, B0); PG8_BAR; PG8_SCHED;
            PG8_LDB(B1, 1, 1); PG8_STAGE(PG8_SB(1, 0), b3, voffB);
            PG8_BAR; PG8_WAIT_L(0); PG8_MMA(0, 1, At, B1); PG8_BAR;
            PG8_LDA(At, 1, 1); PG8_STAGE(PG8_SA(1, 0), a3, voffA);
            PG8_BAR; PG8_WAIT_L(0); PG8_MMA(1, 0, At, B0); PG8_BAR; PG8_SCHED;
            PG8_STAGE(PG8_SB(1, 1), b3 + hsB, voffB);
            PG8_WAIT_V(6); PG8_BAR; PG8_MMA(1, 1, At, B1); PG8_BAR;
            }
        }
        if constexpr (ALIGN_EPI) { if (wr == 0) PG8_BAR; }
        if constexpr (!Epi::AFTER_DRAIN) { E(acc, cur, wr, wc, fr, fq); S.done(cur); }
        if (!has_next) break;
#pragma unroll
        for (int a = 0; a < 2; ++a)
#pragma unroll
            for (int b = 0; b < 2; ++b)
#pragma unroll
                for (int m = 0; m < 4; ++m)
#pragma unroll
                    for (int n = 0; n < 2; ++n) acc[a][b][m][n] = (f32x4){0.f, 0.f, 0.f, 0.f};
        cur = nxt; cA = nA; cB = nB; ++ui;
        if constexpr (ALIGN_EPI) { if (wr == 1) PG8_BAR; }
    }
    PG8_WAIT_V(0);
    if constexpr (!ALIGN_EPI) { if (wr == 0) PG8_BAR; }
    PG8_BAR;
    if constexpr (Epi::AFTER_DRAIN) { E.fused(acc, cur, wr, wc, fr, fq, lds, wid, lane); S.done(cur); }
#undef PG8_SA
#undef PG8_SB
#undef PG8_STAGE
#undef PG8_LDA
#undef PG8_LDB
#undef PG8_MMA
#undef PG8_WAIT_V
#undef PG8_WAIT_L
#undef PG8_BAR
#undef PG8_SCHED
}

}
namespace attn_body {
using bf16=__hip_bfloat16;
using bf16x8=__attribute__((ext_vector_type(8)))short;
using s16x4=__attribute__((ext_vector_type(4)))short;
using f32x16=__attribute__((ext_vector_type(16)))float;
using u32x4=__attribute__((ext_vector_type(4)))unsigned;
constexpr int BATCH=8,NHEAD=16,SEQ=4096,D=64,DM=2560,OPITCH=1024;
constexpr int NW=8,QBLK=32,QB=QBLK*NW,KVBLK=64,NQB=SEQ/QB;
constexpr int ATTN_PITCH=DM, ATTN_UNIT_ROWS=QB;
__device__ __forceinline__ int crow(int r,int hi){return (r&3)+8*(r>>2)+4*hi;}
#define SBAR() __builtin_amdgcn_sched_barrier(0)
__device__ __forceinline__ void cmask(f32x16&p0,f32x16&p1,int jb,int qrel,int hi){
  const float NEG=-INFINITY; int kb=64*jb+4*hi;
  #pragma unroll
  for(int r=0;r<16;++r){int kv=kb+(r&3)+8*(r>>2); if(kv>qrel)p0[r]=NEG; if(kv+32>qrel)p1[r]=NEG;}
}

constexpr int NSLOT=3, SLOTB=8192;
constexpr int LDS_K=0, LDS_V=NSLOT*SLOTB, LDS_WS=2*NSLOT*SLOTB, LDS_OST=LDS_WS+NW*64*4, LDS_BYTES=LDS_OST+NW*4096;
constexpr float C2=0.125f*1.4426950408889634f;
__device__ __forceinline__ void glds16(const void*gsrc,unsigned lds_dst){unsigned keep;
  asm volatile("s_mov_b32 %0, m0\n\ts_mov_b32 m0, %2\n\ts_nop 0\n\tglobal_load_lds_dwordx4 %1, off\n\ts_mov_b32 m0, %0":"=&s"(keep):"v"(gsrc),"s"(lds_dst):"memory");}
__device__ __forceinline__ float max3f(float a,float b,float c){float r;asm("v_max3_f32 %0, %1, %2, %3":"=v"(r):"v"(a),"v"(b),"v"(c));return r;}
__device__ __forceinline__ float max2f(float a,float b){float r;asm("v_max_f32_e32 %0, %1, %2":"=v"(r):"v"(a),"v"(b));return r;}
__device__ __forceinline__ float fadd_s(float a,float b){float r;asm("v_add_f32_e32 %0, %1, %2":"=v"(r):"v"(a),"v"(b));return r;}
__device__ __forceinline__ float fsub_s(float a,float b){float r;asm("v_sub_f32_e32 %0, %1, %2":"=v"(r):"v"(a),"v"(b));return r;}
typedef float f32x2_t __attribute__((ext_vector_type(2))); typedef __bf16 bf16x2_t __attribute__((ext_vector_type(2)));
__device__ __forceinline__ unsigned cvtpk_s(float lo,float hi){f32x2_t v={lo,hi};bf16x2_t b=__builtin_convertvector(v,bf16x2_t);return __builtin_bit_cast(unsigned,b);}
__device__ __forceinline__ float silu_f(float g){ return g*__builtin_amdgcn_rcpf(1.f+__builtin_amdgcn_exp2f(-1.4426950408889634f*g)); }
__device__ __forceinline__ unsigned gate_mul2(unsigned o,unsigned g){ const float o0=__uint_as_float(o<<16),o1=__uint_as_float(o&0xffff0000u),g0=__uint_as_float(g<<16),g1=__uint_as_float(g&0xffff0000u);
  return cvtpk_s(o0*silu_f(g0),o1*silu_f(g1)); }
#define WAIT_BAR(N) asm volatile("s_waitcnt vmcnt(" #N ") lgkmcnt(0)\n\ts_barrier":::"memory")

__device__ __forceinline__ void qkt(f32x16&p0,f32x16&p1,const char*Kslot,const bf16x8*qr,const f32x16&negm,int r32,int hi){
  const char*kb=Kslot+hi*1024+r32*16;
  #pragma unroll
  for(int d0=0;d0<4;++d0){
    const bf16x8 b0=*reinterpret_cast<const bf16x8*>(kb+d0*2048);
    const bf16x8 b1=*reinterpret_cast<const bf16x8*>(kb+d0*2048+512);
    if(d0==0){p0=__builtin_amdgcn_mfma_f32_32x32x16_bf16(b0,qr[0],negm,0,0,0);p1=__builtin_amdgcn_mfma_f32_32x32x16_bf16(b1,qr[0],negm,0,0,0);}
    else{p0=__builtin_amdgcn_mfma_f32_32x32x16_bf16(b0,qr[d0],p0,0,0,0);p1=__builtin_amdgcn_mfma_f32_32x32x16_bf16(b1,qr[d0],p1,0,0,0);}}
}
typedef __attribute__((address_space(3))) const char* lds_cptr;
typedef short v4i16_t __attribute__((ext_vector_type(4)));
__device__ __forceinline__ void kload8(bf16x8*kf,lds_cptr kp){
  kf[0]=*(const __attribute__((address_space(3))) bf16x8*)(kp);      kf[1]=*(const __attribute__((address_space(3))) bf16x8*)(kp+512);
  kf[2]=*(const __attribute__((address_space(3))) bf16x8*)(kp+2048); kf[3]=*(const __attribute__((address_space(3))) bf16x8*)(kp+2560);
  kf[4]=*(const __attribute__((address_space(3))) bf16x8*)(kp+4096); kf[5]=*(const __attribute__((address_space(3))) bf16x8*)(kp+4608);
  kf[6]=*(const __attribute__((address_space(3))) bf16x8*)(kp+6144); kf[7]=*(const __attribute__((address_space(3))) bf16x8*)(kp+6656);
}
__device__ __forceinline__ void kload2(bf16x8*kf,lds_cptr kp,int j){ kf[2*j]=*(const __attribute__((address_space(3))) bf16x8*)(kp+j*2048); kf[2*j+1]=*(const __attribute__((address_space(3))) bf16x8*)(kp+j*2048+512); }
__device__ __forceinline__ s16x4 vtr(lds_cptr p){ return __builtin_bit_cast(s16x4,__builtin_amdgcn_ds_read_tr16_b64_v4i16((__attribute__((address_space(3))) v4i16_t*)p)); }
__device__ __forceinline__ float rowmax(const f32x16&p0,const f32x16&p1){
  float a=max3f(p0[0],p0[1],p1[0]),b=max3f(p0[2],p0[3],p1[1]);a=max3f(a,p1[2],p1[3]);
  #pragma unroll
  for(int r=4;r<16;r+=4){a=max3f(a,p0[r],p0[r+1]);b=max3f(b,p0[r+2],p0[r+3]);a=max3f(a,p1[r],p1[r+1]);b=max3f(b,p1[r+2],p1[r+3]);}
  const float m=max2f(a,b);
  auto rr=__builtin_amdgcn_permlane32_swap(__float_as_uint(m),__float_as_uint(m),false,false);
  return max2f(__uint_as_float(rr[0]),__uint_as_float(rr[1]));
}
__device__ __forceinline__ void pv(f32x16*o,int vb,bf16x8 pa0,bf16x8 pa1,bf16x8 pa2,bf16x8 pa3){
  #pragma unroll
  for(int d0=0;d0<2;++d0){s16x4 lo[4],hi[4];
    #pragma unroll
    for(int ks=0;ks<4;++ks){
      asm volatile("ds_read_b64_tr_b16 %0,%1 offset:%c2":"=&v"(lo[ks]):"v"(vb),"i"(d0*4096+ks*1024):"memory");
      asm volatile("ds_read_b64_tr_b16 %0,%1 offset:%c2":"=&v"(hi[ks]):"v"(vb),"i"(d0*4096+ks*1024+512):"memory");}
    asm volatile("s_waitcnt lgkmcnt(0)":::"memory");SBAR();
    #define PK(k) (bf16x8){lo[k][0],lo[k][1],lo[k][2],lo[k][3],hi[k][0],hi[k][1],hi[k][2],hi[k][3]}
    o[d0]=__builtin_amdgcn_mfma_f32_32x32x16_bf16(pa0,PK(0),o[d0],0,0,0);
    o[d0]=__builtin_amdgcn_mfma_f32_32x32x16_bf16(pa1,PK(1),o[d0],0,0,0);
    o[d0]=__builtin_amdgcn_mfma_f32_32x32x16_bf16(pa2,PK(2),o[d0],0,0,0);
    o[d0]=__builtin_amdgcn_mfma_f32_32x32x16_bf16(pa3,PK(3),o[d0],0,0,0);
    #undef PK
  }
}

#ifndef ATTN_STORE16
#define ATTN_STORE16(p,v) (*(u32x4*)(p)=(v))
#endif
template<int THRL> __device__ __forceinline__ void attn_unit(int b,int h,int qb,const bf16*Q,const bf16* K,const bf16* V,const bf16* Gt,bf16*O,char*shm){
  int tid_=threadIdx.x; asm volatile("":"+v"(tid_)); const int tid=tid_,lane=tid&63,r32=lane&31,hi=lane>>5; const int wid=__builtin_amdgcn_readfirstlane(tid>>6);
  const long rowbase=(long)b*SEQ; const int q0=qb*QB;
  const bf16*Qw=Q+(rowbase+q0+wid*QBLK)*DM+h*D;
  const bf16*Kh=K+(long)(b*4+(h>>2))*64*4096,*Vh=V+(long)(b*4+(h>>2))*64*4096;
  const unsigned lds0=(unsigned)(uintptr_t)shm;
  float*wsf=(float*)(shm+LDS_WS)+wid*64;
  const bf16*ksrc=Kh+wid*512+lane*8;
  const bf16*vsrc=Vh+(wid>>2)*2048+(16*(wid&3)+(lane>>2))*32+(lane&3)*8;
  const unsigned kdst=lds0+LDS_K+wid*1024, vdst=lds0+LDS_V+wid*1024;
  #define DMA_K(t,slot) glds16(ksrc+(long)(t)*4096,(unsigned)__builtin_amdgcn_readfirstlane(kdst+(slot)))
  #define DMA_V(t,slot) glds16(vsrc+(long)(t)*4096,(unsigned)__builtin_amdgcn_readfirstlane(vdst+(slot)))
  const int vb0=(int)(lds0+LDS_V)+((lane>>4)&1)*32+(lane&3)*8+(4*hi+((lane&15)>>2))*64;
  const char*Kbase=shm+LDS_K; bf16x8 kf[8];
  const lds_cptr shm3=(lds_cptr)shm; const lds_cptr kp0=shm3+LDS_K+hi*1024+r32*16; const lds_cptr vp0=shm3+LDS_V+((lane>>4)&1)*32+(lane&3)*8+(4*hi+((lane&15)>>2))*64;
  const int NT=SEQ/KVBLK;
  DMA_K(0,0);DMA_V(0,0);DMA_K(1,SLOTB);
  bf16x8 qr[4];
  #pragma unroll
  for(int d0=0;d0<4;++d0)qr[d0]=*reinterpret_cast<const bf16x8*>(&Qw[(long)r32*DM+d0*16+hi*8]);
  float mhat=0.f,l_reg=0.f;f32x16 o[2];o[0]=f32x16{};o[1]=f32x16{};f32x16 negm=f32x16{};asm volatile("":"+v"(negm));
  const int qrel=wid*QBLK+r32;
  #define CMASK(P0,P1,t) do{}while(0)
  bool resc=false;
  #define START(P0,P1) do{ const float rm=rowmax(P0,P1); resc=false; \
    { const float dl=rm; mhat=fadd_s(mhat,dl); \
      _Pragma("unroll") for(int r=0;r<16;++r){P0[r]=fsub_s(P0[r],dl);P1[r]=fsub_s(P1[r],dl);} \
      _Pragma("unroll") for(int r=0;r<16;++r)negm[r]=-mhat; asm volatile("":"+v"(negm)); } \
    _Pragma("unroll") for(int r=0;r<16;++r)P0[r]=__builtin_amdgcn_exp2f(P0[r]); }while(0)
  #define RESC() do{ if(resc){ asm volatile("s_waitcnt lgkmcnt(0)":::"memory"); \
      _Pragma("unroll") for(int d_=0;d_<2;++d_) _Pragma("unroll") for(int r=0;r<16;++r)o[d_][r]*=wsf[crow(r,hi)]; } }while(0)
  f32x16 pA0,pA1,pB0,pB1;
  int sl_prev=0,sl_cur=0,sl_next=SLOTB;
  #define ROT() do{sl_prev=sl_cur;sl_cur=sl_next;sl_next=(sl_next==(NSLOT-1)*SLOTB)?0:sl_next+SLOTB;}while(0)
  DMA_K(2,2*SLOTB);
  WAIT_BAR(3);
  qkt(pA0,pA1,Kbase,qr,negm,r32,hi);asm volatile("s_nop 15\n\ts_nop 7":"+v"(pA0),"+v"(pA1));CMASK(pA0,pA1,0);
  START(pA0,pA1);
  _Pragma("unroll") for(int r=0;r<16;++r)pA1[r]=__builtin_amdgcn_exp2f(pA1[r]);
  WAIT_BAR(0);
  DMA_K(3,0);DMA_V(1,SLOTB);
  ROT();
  kload8(kf,kp0+sl_cur);
  WAIT_BAR(2);
  s16x4 vlo[8],vhi[8]; u32x4 pw0,pw1,pw2,pw3;
  #define PKW(P,B) cvtpk_s(P[B],P[B+1])
  #define PAF(k) __builtin_bit_cast(bf16x8,pw##k)
  #define VFR(i) (bf16x8){vlo[i][0],vlo[i][1],vlo[i][2],vlo[i][3],vhi[i][0],vhi[i][1],vhi[i][2],vhi[i][3]}
  #define PIN(x) asm volatile("":"+v"(x))
  #define MX3(a,b,c) __builtin_fmaxf(__builtin_fmaxf((a),(b)),(c))
  #define GAPA(MF,A0,A1,A2,A3,W0,W1,PW) do{ MF; sacc+=A0; sacc+=A1; sacc+=A2; sacc+=A3; PIN(sacc); W0; W1; PIN(PW); SBAR(); }while(0)
  #define EX(v) __builtin_amdgcn_exp2f(v)
  #define GAPB(MF,X,B) do{ MF; X[B]=EX(X[B]); X[B+1]=EX(X[B+1]); X[B+2]=EX(X[B+2]); X[B+3]=EX(X[B+3]); PIN(X); SBAR(); }while(0)
  #define VRD(i) do{ vlo[i]=vtr(vp_+(((i)>>2)*4096+((i)&3)*1024)); vhi[i]=vtr(vp_+(((i)>>2)*4096+((i)&3)*1024+512)); }while(0)
  #define KRD(G,j) do{ if(G){ kload2(kf,kp0+sl_next,j); SBAR(); } }while(0)
  #define STEP(C0,C1,P0,P1,t,GK,GV,GL) do{ SBAR(); \
    const lds_cptr vp_=vp0+sl_prev; \
    VRD(0); SBAR(); float sacc=(P0[0]+P0[1]); \
    GAPA(C0=__builtin_amdgcn_mfma_f32_32x32x16_bf16(kf[0],qr[0],negm,0,0,0), P0[2],P0[3],P0[4],P0[5],     pw0[0]=PKW(P0,0), pw0[1]=PKW(P0,2), pw0); \
    VRD(4); SBAR(); GAPA(C1=__builtin_amdgcn_mfma_f32_32x32x16_bf16(kf[1],qr[0],negm,0,0,0), P0[6],P0[7],P0[8],P0[9],     pw0[2]=PKW(P0,4), pw0[3]=PKW(P0,6), pw0); \
    VRD(1); SBAR(); GAPA(C0=__builtin_amdgcn_mfma_f32_32x32x16_bf16(kf[2],qr[1],C0,0,0,0),   P0[10],P0[11],P0[12],P0[13], pw1[0]=PKW(P0,8), pw1[1]=PKW(P0,10), pw1); \
    VRD(5); SBAR(); GAPA(C1=__builtin_amdgcn_mfma_f32_32x32x16_bf16(kf[3],qr[1],C1,0,0,0),   P0[14],P0[15],P1[0],P1[1],   pw1[2]=PKW(P0,12),pw1[3]=PKW(P0,14), pw1); \
    VRD(2); SBAR(); GAPA(C0=__builtin_amdgcn_mfma_f32_32x32x16_bf16(kf[4],qr[2],C0,0,0,0),   P1[2],P1[3],P1[4],P1[5],     pw2[0]=PKW(P1,0), pw2[1]=PKW(P1,2), pw2); \
    VRD(6); SBAR(); GAPA(C1=__builtin_amdgcn_mfma_f32_32x32x16_bf16(kf[5],qr[2],C1,0,0,0),   P1[6],P1[7],P1[8],P1[9],     pw2[2]=PKW(P1,4), pw2[3]=PKW(P1,6), pw2); \
    VRD(3); SBAR(); GAPA(C0=__builtin_amdgcn_mfma_f32_32x32x16_bf16(kf[6],qr[3],C0,0,0,0),   P1[10],P1[11],P1[12],P1[13], pw3[0]=PKW(P1,8), pw3[1]=PKW(P1,10), pw3); \
    VRD(7); SBAR(); GAPA(C1=__builtin_amdgcn_mfma_f32_32x32x16_bf16(kf[7],qr[3],C1,0,0,0),   P1[14],P1[15],0.f,0.f,       pw3[2]=PKW(P1,12),pw3[3]=PKW(P1,14), pw3); \
    l_reg+=sacc; \
    if(GK){DMA_K((t)+3,sl_cur);} if(GV){DMA_V((t)+1,sl_next);} \
    CMASK(C0,C1,t); \
    { float a=MX3(C0[0],C0[1],C1[0]),b=MX3(C0[2],C0[3],C1[1]); a=MX3(a,C1[2],C1[3]); \
      _Pragma("unroll") for(int r=4;r<16;r+=4){a=MX3(a,C0[r],C0[r+1]);b=MX3(b,C0[r+2],C0[r+3]);a=MX3(a,C1[r],C1[r+1]);b=MX3(b,C1[r+2],C1[r+3]);} \
      float rm=__builtin_fmaxf(a,b); { auto rr=__builtin_amdgcn_permlane32_swap(__float_as_uint(rm),__float_as_uint(rm),false,false); rm=__builtin_fmaxf(__uint_as_float(rr[0]),__uint_as_float(rr[1])); } \
      resc=false; \
      if(__builtin_expect(__any(rm>(float)THRL),0)){ const float dl=__builtin_fmaxf(rm,0.f); mhat+=dl; \
        _Pragma("unroll") for(int r=0;r<16;++r){C0[r]-=dl;C1[r]-=dl;} \
        _Pragma("unroll") for(int r=0;r<16;++r)negm[r]=-mhat; asm volatile("":"+v"(negm)); \
        const float f=__builtin_amdgcn_exp2f(-dl); l_reg*=f; if(hi==0)wsf[r32]=f; resc=true; } } \
    SBAR(); \
    GAPB(o[0]=__builtin_amdgcn_mfma_f32_32x32x16_bf16(PAF(0),VFR(0),o[0],0,0,0), C0,0); \
    GAPB(o[1]=__builtin_amdgcn_mfma_f32_32x32x16_bf16(PAF(0),VFR(4),o[1],0,0,0), C0,4); \
    KRD(GL,0); GAPB(o[0]=__builtin_amdgcn_mfma_f32_32x32x16_bf16(PAF(1),VFR(1),o[0],0,0,0), C0,8); \
    KRD(GL,1); GAPB(o[1]=__builtin_amdgcn_mfma_f32_32x32x16_bf16(PAF(1),VFR(5),o[1],0,0,0), C0,12); \
    KRD(GL,2); GAPB(o[0]=__builtin_amdgcn_mfma_f32_32x32x16_bf16(PAF(2),VFR(2),o[0],0,0,0), C1,0); \
    KRD(GL,3); GAPB(o[1]=__builtin_amdgcn_mfma_f32_32x32x16_bf16(PAF(2),VFR(6),o[1],0,0,0), C1,4); \
    GAPB(o[0]=__builtin_amdgcn_mfma_f32_32x32x16_bf16(PAF(3),VFR(3),o[0],0,0,0), C1,8); \
    GAPB(o[1]=__builtin_amdgcn_mfma_f32_32x32x16_bf16(PAF(3),VFR(7),o[1],0,0,0), C1,12); \
    }while(0)
  int t=1;
  #undef CMASK
  #define CMASK(P0,P1,t) do{}while(0)
  for(;t+5<NT;t+=2){
    STEP(pB0,pB1,pA0,pA1,t,true,true,true);     WAIT_BAR(2); RESC(); ROT();
    STEP(pA0,pA1,pB0,pB1,t+1,true,true,true);   WAIT_BAR(2); RESC(); ROT();
  }
  #undef CMASK
  #define CMASK(P0,P1,t) do{}while(0)
  #define ENDW(tt) do{ if((tt)+3<NT){WAIT_BAR(2);} else if((tt)+2<NT){WAIT_BAR(1);} else {WAIT_BAR(0);} }while(0)
  for(;t+1<NT;t+=2){
    STEP(pB0,pB1,pA0,pA1,t,(t+3<NT),(t+1<NT),(t+1<NT));       ENDW(t);   RESC(); ROT();
    STEP(pA0,pA1,pB0,pB1,t+1,(t+4<NT),(t+2<NT),(t+2<NT));     ENDW(t+1); RESC(); ROT();
  }
  const bf16*Gw=Gt+(rowbase+q0+wid*QBLK)*DM+h*D; u32x4 gpre[4];
  _Pragma("unroll") for(int i=0;i<4;++i) gpre[i]=*(const u32x4*)(Gw+(long)(i*8+(lane>>3))*DM+(lane&7)*8);
  STEP(pB0,pB1,pA0,pA1,NT-1,false,false,false); RESC();
  { float sacc=pB0[0]+pB0[1]; _Pragma("unroll") for(int r=2;r<16;++r)sacc+=pB0[r]; _Pragma("unroll") for(int r=0;r<16;++r)sacc+=pB1[r]; l_reg+=sacc;
    pw0=(u32x4){PKW(pB0,0),PKW(pB0,2),PKW(pB0,4),PKW(pB0,6)};pw1=(u32x4){PKW(pB0,8),PKW(pB0,10),PKW(pB0,12),PKW(pB0,14)};pw2=(u32x4){PKW(pB1,0),PKW(pB1,2),PKW(pB1,4),PKW(pB1,6)};pw3=(u32x4){PKW(pB1,8),PKW(pB1,10),PKW(pB1,12),PKW(pB1,14)};
    SBAR(); pv(o,vb0+sl_cur,PAF(0),PAF(1),PAF(2),PAF(3)); }
  #undef PKW
  #undef PAF
  #undef VFR
  #undef PIN
  #undef MX3
  #undef GAPA
  #undef GAPB
  #undef EX
  #undef VRD
  #undef KRD
  #undef STEP
  #undef ENDW
  {auto rr=__builtin_amdgcn_permlane32_swap(__float_as_uint(l_reg),__float_as_uint(l_reg),false,false);l_reg=__uint_as_float(rr[0])+__uint_as_float(rr[1]);}
  if(hi==0)wsf[32+r32]=l_reg;asm volatile("s_waitcnt lgkmcnt(0)":::"memory");
  float rli[16];
  #pragma unroll
  for(int r=0;r<16;++r)rli[r]=__builtin_amdgcn_rcpf(wsf[32+crow(r,hi)]);
  bf16*Ow=O+(rowbase+q0+wid*QBLK)*OPITCH+h*D;
  { bf16*stg=(bf16*)(shm+LDS_OST)+wid*2048;
    #pragma unroll
    for(int r=0;r<16;++r){const int orow=crow(r,hi);
      #pragma unroll
      for(int d0=0;d0<2;++d0)stg[orow*64+d0*32+r32]=__float2bfloat16(o[d0][r]*rli[r]);}
    asm volatile("s_waitcnt lgkmcnt(0)":::"memory");
    #pragma unroll
    for(int i=0;i<4;++i){const int row=i*8+(lane>>3),ch=lane&7; u32x4 v=*(const u32x4*)(stg+row*64+ch*8); const u32x4 gv=gpre[i]; v[0]=gate_mul2(v[0],gv[0]); v[1]=gate_mul2(v[1],gv[1]); v[2]=gate_mul2(v[2],gv[2]); v[3]=gate_mul2(v[3],gv[3]); ATTN_STORE16(Ow+(long)row*OPITCH+ch*8,v);} }
  asm volatile("s_waitcnt lgkmcnt(0)\n\ts_barrier":::"memory");
  #undef DMA_K
  #undef DMA_V
  #undef CMASK
  #undef START
  #undef RESC
  #undef ROT
}
constexpr int ATTN_LDS_BYTES=LDS_BYTES;
template<int THRL=8> __device__ __forceinline__ void attn_phase(char*lds,const bf16*P,const bf16*KT,const bf16*VTt,bf16*Pout,int vcu){
  const int grp=vcu>>3,s=vcu&7,b=grp>>2,kvh=grp&3;
  if(__builtin_amdgcn_readfirstlane(threadIdx.x>>6)<4) __builtin_amdgcn_s_setprio(2);
  for(int i=0;i<8;++i){ const int u=s*8+i; attn_unit<THRL>(b,kvh*4+(u>>4),u&15,P,KT,VTt,P+1536,Pout,lds); }
  __builtin_amdgcn_s_setprio(0);
}
#undef SBAR
#undef WAIT_BAR
}

namespace cg = cooperative_groups;
#define GAS __attribute__((address_space(1)))
#define LAS __attribute__((address_space(3)))
typedef unsigned short bf16;
typedef unsigned v4u __attribute__((ext_vector_type(4)));
typedef unsigned v2u __attribute__((ext_vector_type(2)));
typedef float f32x4 __attribute__((ext_vector_type(4)));
typedef float f32x16 __attribute__((ext_vector_type(16)));
typedef short bf16x8 __attribute__((ext_vector_type(8)));
typedef short s16x4 __attribute__((ext_vector_type(4)));
#define LDS_WAIT() asm volatile("s_waitcnt lgkmcnt(0)" ::: "memory")

#ifndef REP_NAT
#define REP_NAT 1
#endif
#ifndef REP_ATT
#define REP_ATT 1
#endif
#ifndef REP_P1
#define REP_P1 1
#endif
#ifndef REP_SYNC
#define REP_SYNC 1
#endif
#ifndef REP_PP
#define REP_PP 1
#endif
#ifndef REP_VT
#define REP_VT 1
#endif
#ifndef REP_NATC
#define REP_NATC 1
#endif
#ifndef REP_P3L0
#define REP_P3L0 1
#endif
#ifndef REP_P0
#define REP_P0 1
#endif
#ifndef MK_PER_PHASE
#define MK_PER_PHASE 0
#endif
constexpr int NWAVES = 8;
constexpr int BATCH = 8, SEQ = 4096, D = 1024, DEPTH = 4, PLE = 256, GW = 64;
constexpr int T = BATCH * SEQ;
constexpr int NA = 3072, NB = 2560;
constexpr float C2 = 0.125f * 1.4426950408889634f;
constexpr float LOG2E = 1.4426950408889634f;

constexpr size_t MiB = 1u << 20;
constexpr size_t WS_BAR = 0, BAR_ZERO_BYTES = 16384;
constexpr size_t WS_ROPE = 1 * MiB;
constexpr size_t WS_W = 2 * MiB;
constexpr size_t W_AQKG = 0, W_AV = 12 * MiB, W_B = 16 * MiB, W_AO = 26 * MiB, W_BO = 30 * MiB, W_G = 34 * MiB, W_P = 42 * MiB;
constexpr size_t WS_SS = 46 * MiB;
constexpr size_t SS_STAGE = (size_t)T * 16 * 4;
constexpr size_t WS_PB = 64 * MiB;
constexpr size_t WS_U = 128 * MiB, WS_V = 192 * MiB;
constexpr size_t WS_PROJ = 256 * MiB;
constexpr size_t WS_VT = 448 * MiB;
constexpr size_t WS_END = 512 * MiB;

constexpr int RING_BYTES = 131072, LDS_BYTES = 147456;
constexpr int MISC_OFF = LDS_BYTES - 64;

__device__ __forceinline__ unsigned f2bf(float f) { unsigned u = __builtin_bit_cast(unsigned, f); return (u + 0x7fffu + ((u >> 16) & 1u)) >> 16; }
__device__ __forceinline__ unsigned pk2(float lo, float hi) { return f2bf(lo) | (f2bf(hi) << 16); }
__device__ __forceinline__ float wave_sum(float v) {
#pragma unroll
    for (int o = 1; o < 64; o <<= 1) v += __shfl_xor(v, o);
    return v;
}

__device__ __forceinline__ void tr_item(const float* W, int ldw, int k0, int n0, bf16* WT, int K, int drow0, const float* gk, LAS float* scr, int lane, bool p32 = false) {
#pragma unroll 16
    for (int i = 0; i < 32; ++i) { const int kk = 2 * i + (lane >> 5); float w = W[(size_t)(k0 + kk) * ldw + n0 + (lane & 31)]; if (gk) w *= gk[k0 + kk]; scr[kk * 33 + (lane & 31)] = w; }
    LDS_WAIT(); asm volatile("" ::: "memory");
    const int c = lane & 7;
#pragma unroll
    for (int j = 0; j < 4; ++j) { const int n = (lane >> 3) + 8 * j; const LAS float* s = scr + (8 * c) * 33 + n;
        v4u o; o.x = pk2(s[0 * 33], s[1 * 33]); o.y = pk2(s[2 * 33], s[3 * 33]); o.z = pk2(s[4 * 33], s[5 * 33]); o.w = pk2(s[6 * 33], s[7 * 33]);
        const int nd = p32 ? 16 * ((n >> 2) & 1) + 4 * (n >> 3) + (n & 3) : n;
        __builtin_nontemporal_store(o, (GAS v4u*)(WT + (size_t)(drow0 + nd) * K + k0 + 8 * c)); }
    LDS_WAIT(); asm volatile("" ::: "memory");
}

struct Args { const float* in[14]; float* out; unsigned char* ws; int ph_lo, ph_hi; };

__device__ __forceinline__ void p0_prologue(const Args& a, LAS unsigned char* lds, int vcu, int G, int wave) {
    int tid_ = threadIdx.x; asm volatile("" : "+v"(tid_)); const int lane = tid_ & 63;
    unsigned char* ws = a.ws;
    LAS float* scr = (LAS float*)(lds + wave * 16384);
    const int gw = vcu * NWAVES + wave, NGW = G * NWAVES;
    bf16* wbase = (bf16*)(ws + WS_W);
    const float* norm_g = a.in[2];
    constexpr int I0 = 4096, I1 = 2560, I2 = 1024, I3 = 1024, I4 = 2048, I5 = 512, NITEMS = I0 + I1 + I2 + I3 + I4 + I5;
#pragma unroll 1
    for (int pass = 0; pass < 2; ++pass) {
    if (((wave & 1) == 0) == (pass == 0)) {
    for (int it = gw; it < NITEMS; it += NGW) {
        int r = it;
        if (r < I0) { const int j = r / 2048; r %= 2048; const int kb = r / 128, n0 = 32 * (r % 128), sec = n0 >> 10;
            bf16* WT = (sec == 2) ? (bf16*)((unsigned char*)wbase + W_AV) + (size_t)j * 1024 * 1024 : (bf16*)((unsigned char*)wbase + W_AQKG) + (size_t)j * 3072 * 1024;
            const int drow0 = (sec == 2) ? n0 - 2048 : (sec == 3 ? n0 - 1024 : n0);
            tr_item(a.in[3] + (size_t)j * 1024 * 4096, 4096, 64 * kb, n0, WT, 1024, drow0, norm_g + (2 * j) * 1024, scr, lane); continue; }
        r -= I0;
        if (r < I1) { const int j = r / 1280; r %= 1280; const int kb = r / 80, n0 = 32 * (r % 80);
            const bool vg = n0 >= 1280;
            const int drow0 = vg ? n0 : (n0 & ~255) + 128 * ((n0 >> 5) & 1) + 32 * ((n0 >> 6) & 3);
            tr_item(a.in[6] + (size_t)j * 1024 * 2560, 2560, 64 * kb, n0, (bf16*)((unsigned char*)wbase + W_B) + (size_t)j * 2560 * 1024, 1024, drow0, norm_g + (2 * j + 1) * 1024, scr, lane, vg); continue; }
        r -= I1;
        if (r < I2) { const int j = r / 512; r %= 512; const int kb = r / 32, n0 = 32 * (r % 32);
            tr_item(a.in[5] + (size_t)j * 1024 * 1024, 1024, 64 * kb, n0, (bf16*)((unsigned char*)wbase + W_AO) + (size_t)j * 1024 * 1024, 1024, n0, nullptr, scr, lane); continue; }
        r -= I2;
        if (r < I3) { const int j = r / 512; r %= 512; const int kb = r / 32, n0 = 32 * (r % 32);
            tr_item(a.in[9] + (size_t)j * 1024 * 1024, 1024, 64 * kb, n0, (bf16*)((unsigned char*)wbase + W_BO) + (size_t)j * 1024 * 1024, 1024, n0, nullptr, scr, lane); continue; }
        r -= I3;
        if (r < I4) { const int i = r / 512; r %= 512; const int kb = r / 32, n0 = 32 * (r % 32);
            tr_item(a.in[11] + (size_t)i * 1024 * 1024, 1024, 64 * kb, n0, (bf16*)((unsigned char*)wbase + W_G) + (size_t)i * 1024 * 1024, 1024, n0, a.in[10] + i * 1024, scr, lane); continue; }
        r -= I4;
        { const int i = r / 128; r %= 128; const int kb = r / 32, n0 = 32 * (r % 32);
            tr_item(a.in[12] + (size_t)i * 256 * 1024, 1024, 64 * kb, n0, (bf16*)((unsigned char*)wbase + W_P) + (size_t)i * 1024 * 256, 256, n0, nullptr, scr, lane); }
    }
    } else {
    { const f32x4* src = (const f32x4*)a.in[1]; v4u* dst = (v4u*)(ws + WS_PB); const size_t n8 = (size_t)DEPTH * T * PLE / 8;
#pragma unroll 4
      for (size_t i = (size_t)gw * 64 + lane; i < n8; i += (size_t)NGW * 64) { const f32x4 v0 = __builtin_nontemporal_load(src + 2 * i), v1 = __builtin_nontemporal_load(src + 2 * i + 1);
          v4u o; o.x = pk2(v0[0], v0[1]); o.y = pk2(v0[2], v0[3]); o.z = pk2(v1[0], v1[1]); o.w = pk2(v1[2], v1[3]); __builtin_nontemporal_store(o, dst + i); } }
    { const float* x = a.in[0]; bf16* xb = (bf16*)(ws + WS_U); float* ss0 = (float*)(ws + WS_SS);
#pragma unroll 2
      for (int m = gw; m < T; m += NGW) { const f32x4* xr = (const f32x4*)(x + (size_t)m * D) + lane; f32x4 v[4]; float s = 0.f;
#pragma unroll
          for (int j = 0; j < 4; ++j) { v[j] = xr[64 * j]; s += (v[j][0] * v[j][0] + v[j][1] * v[j][1]) + (v[j][2] * v[j][2] + v[j][3] * v[j][3]); }
          s = wave_sum(s);
          v2u* o8 = (v2u*)(xb + (size_t)m * D) + lane;
#pragma unroll
          for (int j = 0; j < 4; ++j) { v2u o; o.x = pk2(v[j][0], v[j][1]); o.y = pk2(v[j][2], v[j][3]); __builtin_nontemporal_store(o, o8 + 64 * j); }
          if (lane < 16) ss0[(size_t)m * 16 + lane] = (lane == 0) ? s : 0.f; } }
    } }
    { const int gid = gw * 64 + lane;
      if (gid < 1024) { const int pos = gid >> 4, j = gid & 15; double th = 1.0; for (int q = 0; q < j; ++q) th *= 0.56234132519034908;
          const double t2 = th * th; double sn = 0.0, cn = 0.0, ts = th, tc = 1.0;
          for (int q = 0; q < 12; ++q) { cn += tc; sn += ts; tc *= -t2 / ((2 * q + 1) * (2 * q + 2)); ts *= -t2 / ((2 * q + 2) * (2 * q + 3)); }
          double cr = 1.0, sr = 0.0; for (int q = 0; q < pos; ++q) { const double c1 = cr * cn - sr * sn, s1 = sr * cn + cr * sn; cr = c1; sr = s1; }
          float* rc = (float*)(ws + WS_ROPE); rc[gid] = (float)cr; rc[1024 + gid] = (float)sr; } }
}

constexpr int NAT_K = 0, NAT_KSLOT = 6144, NAT_V = 67584, NAT_VD = 1072, NAT_TAB = 136192;
__device__ __forceinline__ void natten_phase(LAS unsigned char* lds, const bf16* P, const bf16* VT, bf16* O, const float* rpb, int vcu, int G, int wave) {
    int tid_ = threadIdx.x; asm volatile("" : "+v"(tid_)); const int tid = tid_, lane = tid_ & 63;
    const int q = lane & 15, g = lane >> 4;
    if (wave < 4) __builtin_amdgcn_s_setprio(2);
    for (int wu = vcu; wu < 256; wu += G) {
        const int b = wu >> 5, h = (wu >> 1) & 15, half = wu & 1, kc0 = 16 * half;
        __syncthreads();
        { LAS float* tab = (LAS float*)(lds + NAT_TAB); if (tid < 465) tab[tid] = rpb[h * 465 + tid] * LOG2E; if (tid < 256) tab[512 + tid] = -INFINITY; }
        const unsigned char* kbase = (const unsigned char*)(P + ((size_t)T * 1024) + ((size_t)(b * 16 + h) * SEQ) * 64);
        const unsigned char* vbase = (const unsigned char*)(VT + ((size_t)(b * 16 + h) * 64) * 64 * 64);
        unsigned kg_[3], vg_[3], kl_[3], vl_[3]; int kri[3], vri[3];
#pragma unroll
        for (int k = 0; k < 3; ++k) { const int id = tid + 512 * k, ri = id / 384, rem = id - ri * 384;
            { const int col = rem >> 3, c = rem & 7; kri[k] = ri;
              kg_[k] = (unsigned)(((ri * 64 + kc0 + col) * 64 + 8 * c) * 2);
              kl_[k] = (unsigned)(NAT_K + col * 128 + ((c ^ ((col >> 1) & 7)) << 4)); }
            { const int d = rem / 6, ch = rem - 6 * d; vri[k] = ri;
              vg_[k] = (unsigned)((((ri * 64) + d) * 64 + kc0 + 8 * ch) * 2);
              vl_[k] = (unsigned)(NAT_V + d * NAT_VD + ch * 16); } }
        v4u kreg[3], vreg[3];
#define NAT_ISSUE(first, n) do { const unsigned char* kb_ = kbase + (size_t)(first) * 8192; const unsigned char* vb_ = vbase + (size_t)(first) * 8192; \
        _Pragma("unroll") for (int k = 0; k < 3; ++k) { if (kri[k] < (n)) kreg[k] = *(const v4u*)(kb_ + kg_[k]); if (vri[k] < (n)) vreg[k] = *(const v4u*)(vb_ + vg_[k]); } } while (0)
#define NAT_COMMIT(first, n) do { _Pragma("unroll") for (int k = 0; k < 3; ++k) { \
            if (kri[k] < (n)) { const int sl = ((first) + kri[k]) % 11; *(LAS v4u*)(lds + kl_[k] + sl * NAT_KSLOT) = kreg[k]; } \
            if (vri[k] < (n)) { const int sl = ((first) + vri[k]) % 11; *(LAS v4u*)(lds + vl_[k] + sl * 96) = vreg[k]; } } } while (0)
        NAT_ISSUE(0, 4); NAT_COMMIT(0, 4); NAT_ISSUE(4, 4); NAT_COMMIT(4, 4);
        __syncthreads();
        const int cg2 = wave & 1, c0 = 32 * half + 16 * cg2, wsx = (half ? 8 : 0) + 8 * cg2;
        const int cs = min(max(c0 + q - 8, 0), 48);
        const int vl0 = wsx + 4 * g + kc0 - cs;
        const int swz = ((wsx >> 1) + (q >> 1)) & 7;
        const unsigned kb0 = (unsigned)(NAT_K + (wsx + q) * 128), kb1 = kb0 + 2048u;
        const unsigned ko00 = (unsigned)(((0 + g) ^ swz) << 4), ko01 = (unsigned)(((4 + g) ^ swz) << 4);
        const unsigned vb = (unsigned)(NAT_V + q * NAT_VD + (wsx + 4 * g) * 2); unsigned vb2 = vb + 32u; asm volatile("" : "+v"(vb2));
        const size_t tokh0 = (size_t)(b * 16 + h) * SEQ + (wave >> 1) * 64 + c0 + q;
        const bf16* qptr = P + tokh0 * 64 + 8 * g; const bf16* gptr = P + ((size_t)T * 2048) + tokh0 * 64 + 4 * g;
        bf16x8 qn0 = *(const bf16x8*)(qptr), qn1 = *(const bf16x8*)(qptr + 32);
#pragma unroll 1
        for (int tt = 0; tt < 16 * REP_NATC; ++tt) {
            const int t = tt / REP_NATC; const bool lastrep = (tt % REP_NATC) == REP_NATC - 1;
            const int hi_t = min(max(4 * t + 6, 7), 63), hi_n = (t < 15) ? min(max(4 * t + 10, 7), 63) : hi_t, first = hi_t + 1, nn = lastrep ? hi_n - hi_t : 0;
            if (nn > 0) NAT_ISSUE(first, nn);
            const bf16x8 qf0 = qn0, qf1 = qn1;
            if (t < 15 && lastrep) { const size_t adv = (size_t)(t + 1) * 4 * 64 * 64; qn0 = *(const bf16x8*)(qptr + adv); qn1 = *(const bf16x8*)(qptr + adv + 32); }
            {
                const int r = 4 * t + (wave >> 1), rs = min(max(r - 4, 0), 56);
                const size_t tokq = (size_t)b * SEQ + r * 64 + c0 + q;
                const int s0 = rs % 11;
                const unsigned tb = (unsigned)(NAT_TAB + 4 * ((rs - r + 7) * 31 + kc0 + wsx + 4 * g - c0 - q + 15));
                unsigned a8[8];
#pragma unroll
                for (int j = 0; j < 8; ++j) { const int cb = j >> 2, i = j & 3; a8[j] = ((unsigned)(16 * cb + i + vl0) < 16u) ? tb + 4u * (unsigned)(16 * cb + i) : (unsigned)(NAT_TAB + 2048); }
                f32x4 p[16];
                bf16x8 kc[4], kn[4]; float mx = -1e30f;
#define NAT_LDK(dst, kr_) do { const int sl_ = (s0 + (kr_) >= 11) ? s0 + (kr_) - 11 : s0 + (kr_); const unsigned so_ = (unsigned)sl_ * NAT_KSLOT; \
                    dst[0] = *(const LAS bf16x8*)(lds + kb0 + so_ + ko00); dst[1] = *(const LAS bf16x8*)(lds + kb0 + so_ + ko01); \
                    dst[2] = *(const LAS bf16x8*)(lds + kb1 + so_ + ko00); dst[3] = *(const LAS bf16x8*)(lds + kb1 + so_ + ko01); } while (0)
#define NAT_LDB(kr_) do { _Pragma("unroll") for (int i = 0; i < 4; ++i) { p[2 * (kr_)][i] = *((const LAS float*)(lds + a8[i]) + (kr_) * 31); p[2 * (kr_) + 1][i] = *((const LAS float*)(lds + a8[4 + i]) + (kr_) * 31); } } while (0)
                NAT_LDK(kc, 0); NAT_LDB(0);
#pragma unroll
                for (int kr = 0; kr < 8; ++kr) {
                    if (kr < 7) { NAT_LDK(kn, kr + 1); NAT_LDB(kr + 1); }
                    __builtin_amdgcn_sched_barrier(0);
                    f32x4 a0 = p[2 * kr], a1 = p[2 * kr + 1];
                    a0 = __builtin_amdgcn_mfma_f32_16x16x32_bf16(kc[0], qf0, a0, 0, 0, 0); a1 = __builtin_amdgcn_mfma_f32_16x16x32_bf16(kc[2], qf0, a1, 0, 0, 0);
                    a0 = __builtin_amdgcn_mfma_f32_16x16x32_bf16(kc[1], qf1, a0, 0, 0, 0); a1 = __builtin_amdgcn_mfma_f32_16x16x32_bf16(kc[3], qf1, a1, 0, 0, 0);
                    if (kr > 0) {
                        mx = fmaxf(fmaxf(mx, fmaxf(p[2 * kr - 2][0], p[2 * kr - 2][1])), fmaxf(p[2 * kr - 2][2], p[2 * kr - 2][3]));
                        mx = fmaxf(fmaxf(mx, fmaxf(p[2 * kr - 1][0], p[2 * kr - 1][1])), fmaxf(p[2 * kr - 1][2], p[2 * kr - 1][3])); }
                    p[2 * kr] = a0; p[2 * kr + 1] = a1;
                    __builtin_amdgcn_sched_barrier(0);
#pragma unroll
                    for (int j = 0; j < 4; ++j) kc[j] = kn[j]; }
#undef NAT_LDK
#undef NAT_LDB
                mx = fmaxf(fmaxf(mx, fmaxf(p[14][0], p[14][1])), fmaxf(p[14][2], p[14][3]));
                mx = fmaxf(fmaxf(mx, fmaxf(p[15][0], p[15][1])), fmaxf(p[15][2], p[15][3]));
                mx = fmaxf(mx, __shfl_xor(mx, 16)); mx = fmaxf(mx, __shfl_xor(mx, 32));
                if (__builtin_expect(__any(fabsf(mx) > 64.f), 0)) {
#pragma unroll
                    for (int bk = 0; bk < 16; ++bk)
#pragma unroll
                        for (int i = 0; i < 4; ++i) p[bk][i] -= mx; }
                f32x4 o[4], osum = {0.f, 0.f, 0.f, 0.f};
                const bf16x8 ones = {(short)0x3F80, (short)0x3F80, (short)0x3F80, (short)0x3F80, (short)0x3F80, (short)0x3F80, (short)0x3F80, (short)0x3F80};
#pragma unroll
                for (int db = 0; db < 4; ++db) o[db] = (f32x4){0.f, 0.f, 0.f, 0.f};
                v2u gc[4];
#pragma unroll
                for (int db = 0; db < 4; ++db) gc[db] = *(const v2u*)(gptr + (size_t)t * 4 * 64 * 64 + 16 * db);
                s16x4 vc[8], vn[8];
#define NAT_LDV(dst, kr_) do { const int sl_ = (s0 + (kr_) >= 11) ? s0 + (kr_) - 11 : s0 + (kr_); const unsigned so_ = (unsigned)sl_ * 96u; \
                    _Pragma("unroll") for (int db = 0; db < 4; ++db) { dst[2 * db] = *(const LAS s16x4*)(lds + vb + so_ + db * (16 * NAT_VD)); dst[2 * db + 1] = *(const LAS s16x4*)(lds + vb2 + so_ + db * (16 * NAT_VD)); } } while (0)
                NAT_LDV(vc, 0);
#pragma unroll
                for (int kr = 0; kr < 8; ++kr) {
                    if (kr < 7) NAT_LDV(vn, kr + 1);
#pragma unroll
                    for (int i = 0; i < 4; ++i) { p[2 * kr][i] = __builtin_amdgcn_exp2f(p[2 * kr][i]); p[2 * kr + 1][i] = __builtin_amdgcn_exp2f(p[2 * kr + 1][i]); }
                    v4u pw; pw.x = attn_body::cvtpk_s(p[2 * kr][0], p[2 * kr][1]); pw.y = attn_body::cvtpk_s(p[2 * kr][2], p[2 * kr][3]);
                    pw.z = attn_body::cvtpk_s(p[2 * kr + 1][0], p[2 * kr + 1][1]); pw.w = attn_body::cvtpk_s(p[2 * kr + 1][2], p[2 * kr + 1][3]);
                    const bf16x8 pf = __builtin_bit_cast(bf16x8, pw);
                    __builtin_amdgcn_sched_barrier(0);
                    osum = __builtin_amdgcn_mfma_f32_16x16x32_bf16(ones, pf, osum, 0, 0, 0);
#pragma unroll
                    for (int db = 0; db < 4; ++db) { const bf16x8 va = __builtin_shufflevector(vc[2 * db], vc[2 * db + 1], 0, 1, 2, 3, 4, 5, 6, 7);
                        o[db] = __builtin_amdgcn_mfma_f32_16x16x32_bf16(va, pf, o[db], 0, 0, 0); }
                    __builtin_amdgcn_sched_barrier(0);
#pragma unroll
                    for (int j = 0; j < 8; ++j) vc[j] = vn[j]; }
#undef NAT_LDV
                const float inv = __builtin_amdgcn_rcpf(osum[0]);
                bf16* orow = O + tokq * D + h * 64;
                v2u wq[4];
#pragma unroll
                for (int db = 0; db < 4; ++db) { const v2u gv = gc[db];
                    const float g0 = __uint_as_float(gv.x << 16), g1 = __uint_as_float(gv.x & 0xffff0000u), g2 = __uint_as_float(gv.y << 16), g3 = __uint_as_float(gv.y & 0xffff0000u);
                    wq[db].x = attn_body::cvtpk_s(o[db][0] * inv * attn_body::silu_f(g0), o[db][1] * inv * attn_body::silu_f(g1));
                    wq[db].y = attn_body::cvtpk_s(o[db][2] * inv * attn_body::silu_f(g2), o[db][3] * inv * attn_body::silu_f(g3)); }
#pragma unroll
                for (int pr = 0; pr < 2; ++pr) { v2u wa = wq[2 * pr], wb = wq[2 * pr + 1];
                    { auto r0 = __builtin_amdgcn_permlane16_swap(wa.x, wb.x, false, false); wa.x = r0[0]; wb.x = r0[1];
                      auto r1 = __builtin_amdgcn_permlane16_swap(wa.y, wb.y, false, false); wa.y = r1[0]; wb.y = r1[1]; }
                    v4u ww; ww.x = wa.x; ww.y = wa.y; ww.z = wb.x; ww.w = wb.y;
                    const int d0 = (g & 1) ? 16 * (2 * pr + 1) + 4 * (g - 1) : 16 * (2 * pr) + 4 * g;
                    *(v4u*)(orow + d0) = ww; }
            }
            asm volatile("s_waitcnt lgkmcnt(0)\n\ts_barrier" ::: "memory");
            if (nn > 0) NAT_COMMIT(first, nn);
            asm volatile("s_waitcnt lgkmcnt(0)\n\ts_barrier" ::: "memory");
        }
#undef NAT_ISSUE
#undef NAT_COMMIT
    }
    __builtin_amdgcn_s_setprio(0);
}

__device__ __forceinline__ void final_norm(const bf16* r, float* out, const float* ssp, const float* g, int vcu, int G, int wave) {
    int tid_ = threadIdx.x; asm volatile("" : "+v"(tid_)); const int lane = tid_ & 63;
    const int gw = vcu * NWAVES + wave, NGW = G * NWAVES;
    f32x4 gv[4];
#pragma unroll
    for (int j = 0; j < 4; ++j) gv[j] = *((const f32x4*)g + 2 * lane + (j & 1) + 128 * (j >> 1));
    for (int m = gw; m < T; m += NGW) {
        float s = (lane < 16) ? ssp[(size_t)m * 16 + lane] : 0.f; s = wave_sum(s);
        const float rs = rsqrtf(s * (1.0f / D) + 1e-6f);
        const v4u* rr = (const v4u*)(r + (size_t)m * D) + lane; f32x4* xo = (f32x4*)(out + (size_t)m * D) + 2 * lane;
#pragma unroll
        for (int j2 = 0; j2 < 2; ++j2) { const v4u w = __builtin_nontemporal_load(rr + 64 * j2);
            f32x4 v0, v1; v0[0] = __uint_as_float(w.x << 16); v0[1] = __uint_as_float(w.x & 0xffff0000u); v0[2] = __uint_as_float(w.y << 16); v0[3] = __uint_as_float(w.y & 0xffff0000u);
            v1[0] = __uint_as_float(w.z << 16); v1[1] = __uint_as_float(w.z & 0xffff0000u); v1[2] = __uint_as_float(w.w << 16); v1[3] = __uint_as_float(w.w & 0xffff0000u);
            __builtin_nontemporal_store(v0 * rs * gv[2 * j2], xo + 128 * j2); __builtin_nontemporal_store(v1 * rs * gv[2 * j2 + 1], xo + 128 * j2 + 1); }
    }
}

typedef GAS unsigned gu32;
#define XB_TMO      128
#define XB_XCNT(j)  (256  + 64 * (j))
#define XB_XSUB(j)  (1280 + 64 * (j))
#define XB_XGEN(j)  (2304 + 64 * (j))
#define XB_TOP      3328
#define XB_TOPGEN   3392
#define XCD_BAR_WORDS 3456
#define XB_SPIN_CAP (1u << 18)

__device__ __forceinline__ unsigned xb_ld(unsigned* p)              { return __hip_atomic_load(p, __ATOMIC_RELAXED, __HIP_MEMORY_SCOPE_AGENT); }
__device__ __forceinline__ unsigned xb_add(unsigned* p, unsigned v) { return __hip_atomic_fetch_add(p, v, __ATOMIC_RELAXED, __HIP_MEMORY_SCOPE_AGENT); }
__device__ __forceinline__ unsigned xb_xcc_id() { return (unsigned)__builtin_amdgcn_s_getreg((3 << 11) | 20) & 0xFu; }
#define XB_SPIN(cond, bar) do { unsigned _sp = 0; while (cond) { __builtin_amdgcn_s_sleep(1); \
    if ((++_sp & 255u) == 0u) { if (xb_ld(&(bar)[XB_TMO])) break; if (_sp > XB_SPIN_CAP) { atomicAdd(&(bar)[XB_TMO], 1u); break; } } } } while (0)

struct XcdBarrier {
    unsigned* bar; unsigned x;
    volatile LAS unsigned* st;
};

__device__ __forceinline__ XcdBarrier xcd_barrier_post(unsigned* bar, volatile LAS unsigned* st) {
    XcdBarrier b; b.bar = bar; b.x = xb_xcc_id(); b.st = st;
    if (threadIdx.x == 0) (void)xb_add(&bar[XB_XCNT(b.x)], 1u);
    return b;
}
__device__ __forceinline__ void xcd_barrier_complete(unsigned* bar, unsigned x, unsigned& nloc, unsigned& nx) {
    const unsigned G = gridDim.x * gridDim.y * gridDim.z;
    unsigned sum, cnt, mine, sp = 0u;
    for (;;) {
        sum = 0u; cnt = 0u; mine = 0u;
#pragma unroll
        for (unsigned j = 0; j < 16; ++j) { const unsigned c = xb_ld(&bar[XB_XCNT(j)]); sum += c; cnt += (c > 0u) ? 1u : 0u; mine = (j == x) ? c : mine; }
        if (sum == G) break;
        __builtin_amdgcn_s_sleep(1);
        if ((++sp & 255u) == 0u) { if (xb_ld(&bar[XB_TMO])) break; if (sp > XB_SPIN_CAP) { atomicAdd(&bar[XB_TMO], 1u); break; } }
    }
    nloc = mine > 0u ? mine : 1u; nx = cnt > 0u ? cnt : 1u;
}

__device__ __forceinline__ void xcd_barrier(const XcdBarrier& b) {
    asm volatile("s_waitcnt vmcnt(0)" ::: "memory");
    __syncthreads();
    if (threadIdx.x == 0) {
        unsigned* bar = b.bar;
        __builtin_amdgcn_s_waitcnt(0);
        unsigned nloc = b.st[0], nx = b.st[1];
        if (nloc == 0u) { xcd_barrier_complete(bar, b.x, nloc, nx); b.st[0] = nloc; b.st[1] = nx; }
        const unsigned old = xb_add(&bar[XB_XSUB(b.x)], 1u);
        const unsigned gen = old / nloc;
        if (old + 1u == (gen + 1u) * nloc) {
            __builtin_amdgcn_fence(__ATOMIC_RELEASE, "agent");
            asm volatile("s_waitcnt vmcnt(0)" ::: "memory");
            const unsigned og = xb_add(&bar[XB_TOP], 1u);
            const unsigned tg = og / nx;
            if (og + 1u == (tg + 1u) * nx) xb_add(&bar[XB_TOPGEN], 1u);
            else XB_SPIN(xb_ld(&bar[XB_TOPGEN]) == tg, bar);
            __builtin_amdgcn_fence(__ATOMIC_ACQUIRE, "agent");
            xb_add(&bar[XB_XGEN(b.x)], 1u);
            asm volatile("s_waitcnt vmcnt(0)" ::: "memory");
        } else {
            XB_SPIN(xb_ld(&bar[XB_XGEN(b.x)]) == gen, bar);
            __builtin_amdgcn_fence(__ATOMIC_ACQUIRE, "agent");
            asm volatile("s_waitcnt vmcnt(0)" ::: "memory");
        }
    }
    __syncthreads();
}
constexpr int N_PHASES = 2 + 4 * DEPTH;
__global__ void __launch_bounds__(NWAVES * 64, 2) mk_fwd(Args args) {
    extern __shared__ __attribute__((aligned(16))) unsigned char lds[];
    LAS unsigned char* L = (LAS unsigned char*)lds;
    const int tid = threadIdx.x, lane = tid & 63, wave = __builtin_amdgcn_readfirstlane(tid >> 6);
    const int G = gridDim.x, bx = blockIdx.x, vcu = (G % 8 == 0) ? (bx % 8) * (G / 8) + bx / 8 : bx;
    unsigned char* ws = args.ws;
    const int lo = args.ph_lo, hi = args.ph_hi;
#define IN(k) (lo <= (k) && (k) < hi)
    if (tid < 2) ((volatile LAS unsigned*)(L + MISC_OFF))[tid] = 0u;
    __syncthreads();
    XcdBarrier xbar; xbar.bar = (unsigned*)(ws + WS_BAR); xbar.x = 0; xbar.st = (volatile LAS unsigned*)(L + MISC_OFF);
#if MK_PER_PHASE
    if (hi - lo > 1) xbar = xcd_barrier_post((unsigned*)(ws + WS_BAR), (volatile LAS unsigned*)(L + MISC_OFF));
#else
    if (IN(0) && bx == 0) for (int i = tid; i < (int)(BAR_ZERO_BYTES / 4); i += NWAVES * 64) ((unsigned*)(ws + WS_BAR))[i] = 0u;
#endif
#define SEAM(k) do { if (IN(k) && IN((k) + 1)) for (int rep_ = 0; rep_ < REP_SYNC; ++rep_) { if ((k) == 0) cg::this_grid().sync(); else xcd_barrier(xbar); } } while (0)
#ifndef SKIP_P0
    for (int rep = 0; rep < REP_P0; ++rep)
    if (IN(0)) p0_prologue(args, L, vcu, G, wave);
#endif
    SEAM(0);
#if !MK_PER_PHASE
    xbar = xcd_barrier_post((unsigned*)(ws + WS_BAR), (volatile LAS unsigned*)(L + MISC_OFF));
#endif
    bf16* OB = (bf16*)args.out;
    bf16* PROJ = (bf16*)(ws + WS_PROJ); bf16* VT = (bf16*)(ws + WS_VT);
    const float* ropec = (const float*)(ws + WS_ROPE); const float* ropes = ropec + 1024;
#pragma unroll 1
    for (int i = 0; i < DEPTH; ++i) {
        const int j = i >> 1; const bool isA = (i & 1) == 0; const int pb0 = 1 + 4 * i;
        bf16* XB = (bf16*)(ws + ((i & 1) ? WS_V : WS_U));
        bf16* PP = (bf16*)(ws + ((i & 1) ? WS_U : WS_V));
        const float* ss_in = (const float*)(ws + WS_SS + (size_t)(2 * i) * SS_STAGE);
        float* ss_mid = (float*)(ws + WS_SS + (size_t)(2 * i + 1) * SS_STAGE);
        float* ss_out = (float*)(ws + WS_SS + (size_t)(2 * i + 2) * SS_STAGE);
        const bf16* wb = (const bf16*)(ws + WS_W);
        for (int rep = 0; rep < REP_P1; ++rep)
        if (IN(pb0)) {
            const bool ppfirst = (bx & 1) != 0;
#pragma unroll 1
            for (int pass = 0; pass < 2; ++pass) {
            if ((pass == 0) != ppfirst) {
#ifndef SKIP_G1A
            if (isA) {
                { pg8::Gemm g{XB, (const bf16*)((const unsigned char*)wb + W_AQKG) + (size_t)j * 3072 * 1024, T, NA, D, D, D}; pg8::StaticOrder S; S.init(T, NA, G, bx);
                  pg8::EpiBf16S<1, true> E{PROJ, NA, ss_in, 1024, C2};
                  pg8::gemm_phase<pg8::EpiBf16S<1, true>, pg8::StaticOrder, true, true>(L, g, S, E); }
                for (int rvt = 0; rvt < REP_VT; ++rvt)
                { pg8::Gemm g{(const bf16*)((const unsigned char*)wb + W_AV) + (size_t)j * 1024 * 1024, XB, D, T, D, D, D}; pg8::StaticOrder S; S.init(D, T, G, bx);
                  pg8::EpiBf16S<2, true> E{VT, T, ss_in, 0, 1.f};
                  pg8::gemm_phase<pg8::EpiBf16S<2, true>, pg8::StaticOrder, true, true>(L, g, S, E); }
            }
#endif
#ifndef SKIP_G1B
            if (!isA) {
                pg8::Gemm g{XB, (const bf16*)((const unsigned char*)wb + W_B) + (size_t)j * 2560 * 1024, T, NB, D, D, D}; pg8::StaticOrder S; S.init(T, NB, G, bx);
                pg8::EpiQKRope E{PROJ, NB, ss_in, args.in[7] + j * 64, args.in[8] + j * 64, ropec, ropes, C2, VT, VT + (size_t)8 * 1024 * 1024};
                pg8::gemm_phase<pg8::EpiQKRope, pg8::StaticOrder, true, true>(L, g, S, E);
            }
#endif
            } else {
#ifndef SKIP_GPP
            for (int rpp = 0; rpp < REP_PP; ++rpp)
            { pg8::Gemm g{(const bf16*)(ws + WS_PB) + (size_t)i * T * PLE, (const bf16*)((const unsigned char*)wb + W_P) + (size_t)i * 1024 * 256, T, D, PLE, PLE, PLE}; pg8::StaticOrder S; S.init(T, D, G, bx);
              pg8::EpiBf16S<0> E{PP, D, nullptr, 0, 1.f};
              pg8::gemm_phase<pg8::EpiBf16S<0>, pg8::StaticOrder, true, true>(L, g, S, E); }
#endif
            } }
        }
        SEAM(pb0);
        if (IN(pb0 + 1)) {
#ifndef SKIP_NAT
            for (int rep = 0; rep < REP_NAT; ++rep)
            if (isA) natten_phase(L, PROJ, VT, OB, args.in[4] + (size_t)j * 16 * 465, vcu, G, wave);
#endif
#ifndef SKIP_ATT
            for (int rep = 0; rep < REP_ATT; ++rep)
            if (!isA) attn_body::attn_phase<8>((char*)lds, (const attn_body::bf16*)PROJ, (const attn_body::bf16*)VT, (const attn_body::bf16*)(VT + (size_t)8 * 1024 * 1024), (attn_body::bf16*)OB, vcu);
#endif
        }
        SEAM(pb0 + 1);
#ifndef SKIP_G3
        for (int rep = 0; rep < ((i == 0) ? REP_P3L0 : 1); ++rep)
        if (IN(pb0 + 2)) {
            const bf16* wo = (const bf16*)((const unsigned char*)wb + (isA ? W_AO : W_BO)) + (size_t)j * 1024 * 1024;
            pg8::Gemm g{OB, wo, T, D, D, D, D}; pg8::StaticOrder S; S.init(T, D, G, bx);
            pg8::EpiResid<false> E{i == 0 ? args.in[0] : nullptr, XB, XB, nullptr, nullptr, ss_mid};
            pg8::gemm_phase<pg8::EpiResid<false>, pg8::StaticOrder, true, true>(L, g, S, E);
        }
#endif
        SEAM(pb0 + 2);
#ifndef SKIP_G4
        if (IN(pb0 + 3)) {
            pg8::Gemm g{XB, (const bf16*)((const unsigned char*)wb + W_G) + (size_t)i * 1024 * 1024, T, D, D, D, D}; pg8::StaticOrder S; S.init(T, D, G, bx);
            pg8::EpiResid<true> E{nullptr, XB, PP, PP, ss_mid, ss_out};
            pg8::gemm_phase<pg8::EpiResid<true>, pg8::StaticOrder, true, true>(L, g, S, E);
        }
#endif
        SEAM(pb0 + 3);
    }
    if (IN(N_PHASES - 1)) final_norm((const bf16*)(ws + WS_U), args.out, (const float*)(ws + WS_SS + (size_t)8 * SS_STAGE), args.in[13], vcu, G, wave);
#undef IN
#undef SEAM
}

extern "C" void kernel_launch(void* const* d_in, const int* in_sizes, int n_in, void* d_out, int out_size, void* d_ws, size_t ws_size, hipStream_t stream) {
    static int grid = 0;
    if (grid == 0) {
        if (n_in != 14 || out_size != T * D || ws_size < WS_END) { fprintf(stderr, "kernel_launch: unexpected shapes: n_in %d out %d ws %zu (need %zu)\n", n_in, out_size, ws_size, (size_t)WS_END); grid = -1; return; }
        int dev = 0, cus = 0, per_cu = 0;
        hipGetDevice(&dev); hipDeviceGetAttribute(&cus, hipDeviceAttributeMultiprocessorCount, dev);
        if (hipFuncSetAttribute((const void*)mk_fwd, hipFuncAttributeMaxDynamicSharedMemorySize, LDS_BYTES) != hipSuccess) { fprintf(stderr, "kernel_launch: hipFuncSetAttribute failed\n"); grid = -1; return; }
        if (hipOccupancyMaxActiveBlocksPerMultiprocessor(&per_cu, (const void*)mk_fwd, NWAVES * 64, LDS_BYTES) != hipSuccess || per_cu < 1) { fprintf(stderr, "kernel_launch: occupancy query says %d\n", per_cu); per_cu = 1; }
        (void)hipGetLastError();
        grid = cus;
        fprintf(stderr, "kernel_launch: grid %d (occupancy query %d/CU), ws %zu\n", grid, per_cu, ws_size);
    }
    if (grid < 0) return;
#if MK_PER_PHASE
    if (hipMemsetAsync((char*)d_ws + WS_BAR, 0, BAR_ZERO_BYTES, stream) != hipSuccess) { fprintf(stderr, "kernel_launch: memset failed\n"); return; }
#endif
    Args a{};
    for (int i = 0; i < 14; ++i) a.in[i] = (const float*)d_in[i];
    a.out = (float*)d_out; a.ws = (unsigned char*)d_ws;
#if MK_PER_PHASE
    for (int ph = 0; ph < N_PHASES; ++ph) { a.ph_lo = ph; a.ph_hi = ph + 1; hipLaunchKernelGGL(mk_fwd, dim3(grid), dim3(NWAVES * 64), LDS_BYTES, stream, a); }
#else
    a.ph_lo = 0; a.ph_hi = N_PHASES;
    void* kargs[] = {&a};
    const hipError_t e = hipLaunchCooperativeKernel((const void*)mk_fwd, dim3(grid), dim3(NWAVES * 64), kargs, LDS_BYTES, stream);
    if (e != hipSuccess) fprintf(stderr, "kernel_launch: cooperative launch failed: %s (grid %d)\n", hipGetErrorString(e), grid);
#endif
}
```

```cpp
#include <hip/hip_runtime.h>
#include <hip/hip_cooperative_groups.h>
#include <hip/hip_bf16.h>
#include <cstdio>
#include <cstdint>
#include <cmath>
namespace pg8 {
#define PG8_LAS __attribute__((address_space(3)))
typedef unsigned short bf16_t;
typedef short bf16x8 __attribute__((ext_vector_type(8)));
typedef float f32x4 __attribute__((ext_vector_type(4)));
typedef unsigned u32x4 __attribute__((ext_vector_type(4)));
constexpr int BM = 256, BK = 64, HALF = 128, HTB = HALF * BK * 2  , STAGE_BYTES = 8 * HTB, NXCD = 8, WGM = 8;

__host__ __device__ __forceinline__ int lds_byte(int r, int c) { const int st = (r >> 4) * 2 + (c >> 5), rr = r & 15, cc = c & 31, ob = rr * 64 + cc * 2; return st * 1024 + (ob ^ (((ob >> 9) & 1) << 5)); }
__host__ __device__ __forceinline__ void stage_rc(int b, int& R, int& C) { const int st = b / 1024, sb = b % 1024, swz = sb ^ (((sb >> 9) & 1) << 5); R = (st >> 1) * 16 + swz / 64; C = (st & 1) * 32 + (swz % 64) / 2; }
__host__ __device__ __forceinline__ int perm32(int rho) { const int n = rho >> 4, i = rho & 15; return 8 * (i >> 2) + 4 * n + (i & 3); }

struct Unit { int pm, pn; };
struct Gemm { const bf16_t* A; const bf16_t* Bt; int M, N, K, lda, ldb; };

struct StaticOrder {
    int nM, nN, nwg, G, c;
    __host__ __device__ void init(int M, int N, int G_, int c_) { nM = M / BM; nN = N / BM; nwg = nM * nN; G = G_; c = c_; }
    __host__ __device__ bool next(int i, Unit& u) const {
        const long L = (long)i * G + c; if (L >= nwg) return false;
        int wgid = (int)L; { const int q = nwg / NXCD, r = nwg % NXCD, xcd = wgid % NXCD, off = wgid / NXCD; wgid = (xcd < r ? xcd * (q + 1) : r * (q + 1) + (xcd - r) * q) + off; }
        const int nig = WGM * nN, gid = wgid / nig, fm = gid * WGM, gsz = (nM - fm) < WGM ? (nM - fm) : WGM;
        u.pm = fm + ((wgid % nig) % gsz); u.pn = (wgid % nig) / gsz; return true;
    }
    __device__ __forceinline__ void a_ready(const Unit&) const {}
    __device__ __forceinline__ void done(const Unit&) const {}
};

__device__ __forceinline__ unsigned cvt_pk_bf16(float lo, float hi) { unsigned r; asm volatile("v_cvt_pk_bf16_f32 %0, %1, %2" : "=v"(r) : "v"(lo), "v"(hi)); return r; }
typedef unsigned u32x2 __attribute__((ext_vector_type(2)));
constexpr float NORM_EPS = 1e-6f;
constexpr int DMODEL = 1024, NSLOT_SS = 16;
__device__ __forceinline__ float row_rstd(const float* ssp, int row, int fq) {
    const f32x4 v = *(const f32x4*)(ssp + (size_t)row * NSLOT_SS + 4 * fq);
    float s = (v[0] + v[1]) + (v[2] + v[3]);
    s += __shfl_xor(s, 16); s += __shfl_xor(s, 32);
    return rsqrtf(s * (1.0f / DMODEL) + NORM_EPS);
}
__device__ __forceinline__ float sigmoid_f(float x) { return __builtin_amdgcn_rcpf(1.f + __builtin_amdgcn_exp2f(-1.4426950408889634f * x)); }

template <int MODE, bool HT = false> struct EpiBf16S {
    static constexpr bool PERM = true, AFTER_DRAIN = false;
    bf16_t* O; int ldc; const float* ssp; int q_cols; float scale0;
    __device__ __forceinline__ void operator()(const f32x4 (&acc)[2][2][4][2], const Unit& u, int wr, int wc, int fr, int fq) const {
        asm volatile("" : "+v"(fr), "+v"(fq));
        const int row0 = u.pm * BM + wr * 64 + fr, col0 = u.pn * BM + wc * 32 + 8 * fq;
        const float sc = (MODE == 1 && u.pn * BM < q_cols) ? scale0 : 1.f;
        float cs[2][8];
        if (MODE == 2) {
            const int cj = col0 + (fr >> 3) * HALF + (fr & 7);
            float s = 0.f;
#pragma unroll
            for (int k = 0; k < 4; ++k) { const f32x4 v = *(const f32x4*)(ssp + (size_t)cj * NSLOT_SS + 4 * k); s += (v[0] + v[1]) + (v[2] + v[3]); }
            const float r = rsqrtf(s * (1.0f / DMODEL) + NORM_EPS);
            const int lane = fq * 16 + fr;
#pragma unroll
            for (int bj = 0; bj < 2; ++bj)
#pragma unroll
                for (int e = 0; e < 8; ++e) cs[bj][e] = __shfl(r, (lane & 48) + bj * 8 + e);
        }
#pragma unroll
        for (int ai = 0; ai < 2; ++ai)
#pragma unroll
            for (int m = 0; m < 4; ++m) { const int row = row0 + ai * HALF + m * 16; bf16_t* rowp = O + (size_t)row * ldc + col0;
                float rs = sc; if (MODE == 1) rs *= row_rstd(ssp, row, fq);
#pragma unroll
                for (int bj = 0; bj < 2; ++bj) { f32x4 v0 = acc[ai][bj][m][0], v1 = acc[ai][bj][m][1];
                    bf16_t* dst = rowp + bj * HALF;
                    if (HT && MODE == 1) { const int c = col0 + bj * HALF; dst = O + ((size_t)(c >> 10) << 25) + ((size_t)(((row >> 12) << 4) + ((c >> 6) & 15)) * 4096 + (row & 4095)) * 64 + (c & 63); }
                    if (HT && MODE == 2) { const int c = col0 + bj * HALF; dst = O + ((((size_t)(((c >> 12) << 4) + (row >> 6)) * 64 + ((c >> 6) & 63)) * 64 + (row & 63)) * 64) + (c & 63); }
                    if (MODE == 2) { v0[0] *= cs[bj][0]; v0[1] *= cs[bj][1]; v0[2] *= cs[bj][2]; v0[3] *= cs[bj][3]; v1[0] *= cs[bj][4]; v1[1] *= cs[bj][5]; v1[2] *= cs[bj][6]; v1[3] *= cs[bj][7]; }
                    else if (MODE == 1) { v0 = v0 * rs; v1 = v1 * rs; }
                    u32x4 w; w.x = cvt_pk_bf16(v0[0], v0[1]); w.y = cvt_pk_bf16(v0[2], v0[3]); w.z = cvt_pk_bf16(v1[0], v1[1]); w.w = cvt_pk_bf16(v1[2], v1[3]);
                    *(u32x4*)dst = w; } }
    }
};

struct EpiQKRope {
    static constexpr bool PERM = false, AFTER_DRAIN = false;
    bf16_t* O; int ldc; const float* ssp; const float* qg; const float* kg; const float* ropec; const float* ropes; float c2;
    bf16_t* KT; bf16_t* VTt;
    __device__ __forceinline__ void operator()(const f32x4 (&acc)[2][2][4][2], const Unit& u, int wr, int wc, int fr, int fq) const {
        asm volatile("" : "+v"(fr), "+v"(fq));
        const int row0 = u.pm * BM + wr * 64 + fr, col0 = u.pn * BM + wc * 64 + 4 * fq;
        const bool qk = u.pn < 5;
        if (!qk) {
            const int colv = u.pn * BM + wc * 32 + 8 * fq;
#pragma unroll
            for (int ai = 0; ai < 2; ++ai)
#pragma unroll
                for (int m = 0; m < 4; ++m) { const int row = row0 + ai * HALF + m * 16; bf16_t* rowp = O + (size_t)row * ldc + colv;
                    const float rs = row_rstd(ssp, row, fq);
#pragma unroll
                    for (int bj = 0; bj < 2; ++bj) { const f32x4 v0 = acc[ai][bj][m][0] * rs, v1 = acc[ai][bj][m][1] * rs;
                        u32x4 w; w.x = cvt_pk_bf16(v0[0], v0[1]); w.y = cvt_pk_bf16(v0[2], v0[3]); w.z = cvt_pk_bf16(v1[0], v1[1]); w.w = cvt_pk_bf16(v1[2], v1[3]);
                        bf16_t* dst = rowp + bj * HALF;
                        if (u.pn == 5) { const int kvh = 2 * bj + (wc >> 1), s = row & 4095;
                            dst = VTt + ((((size_t)((row >> 12) * 4 + kvh) * 64 + (s >> 6)) * 2 + (wc & 1)) * 64 + (s & 63)) * 32 + 8 * fq; }
                        *(u32x4*)dst = w; } }
            return;
        }
        const float* gp = (u.pn < 4) ? qg : kg; const float osc = (u.pn < 4) ? c2 : 1.f;
#pragma unroll
        for (int ai = 0; ai < 2; ++ai)
#pragma unroll
            for (int m = 0; m < 4; ++m) { const int row = row0 + ai * HALF + m * 16; bf16_t* rowp = O + (size_t)row * ldc + col0;
                const float rs = row_rstd(ssp, row, fq);
                f32x4 v[2][2];
#pragma unroll
                for (int bj = 0; bj < 2; ++bj)
#pragma unroll
                    for (int n = 0; n < 2; ++n) v[bj][n] = acc[ai][bj][m][n] * rs;
                if (qk) {
                    const float* gp2 = gp; asm volatile("" : "+s"(gp2));
                    f32x4 gn[2][2];
#pragma unroll
                    for (int bj = 0; bj < 2; ++bj)
#pragma unroll
                        for (int n = 0; n < 2; ++n) gn[bj][n] = *(const f32x4*)(gp2 + 32 * bj + 16 * n + 4 * fq);
                    float sq = 0.f;
#pragma unroll
                    for (int bj = 0; bj < 2; ++bj)
#pragma unroll
                        for (int n = 0; n < 2; ++n) sq += (v[bj][n][0] * v[bj][n][0] + v[bj][n][1] * v[bj][n][1]) + (v[bj][n][2] * v[bj][n][2] + v[bj][n][3] * v[bj][n][3]);
                    sq += __shfl_xor(sq, 16); sq += __shfl_xor(sq, 32);
                    const float hr = rsqrtf(sq * (1.0f / 64.0f) + NORM_EPS);
                    const int t = row & 4095, prow = t >> 6, pcol = t & 63;
#pragma unroll
                    for (int bj = 0; bj < 2; ++bj) { const int pos = bj ? pcol : prow;
                        const f32x4 c = *(const f32x4*)(ropec + pos * 16 + 4 * fq), s = *(const f32x4*)(ropes + pos * 16 + 4 * fq);
                        const f32x4 x1 = v[bj][0] * hr * gn[bj][0], x2 = v[bj][1] * hr * gn[bj][1];
                        v[bj][0] = (x1 * c - x2 * s) * osc; v[bj][1] = (x2 * c + x1 * s) * osc; }
                }
#pragma unroll
                for (int bj = 0; bj < 2; ++bj) {
                    u32x2 w0, w1;
                    w0.x = cvt_pk_bf16(v[bj][0][0], v[bj][0][1]); w0.y = cvt_pk_bf16(v[bj][0][2], v[bj][0][3]);
                    w1.x = cvt_pk_bf16(v[bj][1][0], v[bj][1][1]); w1.y = cvt_pk_bf16(v[bj][1][2], v[bj][1][3]);
                    { auto r0 = __builtin_amdgcn_permlane16_swap(w0.x, w1.x, false, false); w0.x = r0[0]; w1.x = r0[1];
                      auto r1 = __builtin_amdgcn_permlane16_swap(w0.y, w1.y, false, false); w0.y = r1[0]; w1.y = r1[1]; }
                    u32x4 ww; ww.x = w0.x; ww.y = w0.y; ww.z = w1.x; ww.w = w1.y;
                    const int dd = 32 * bj + ((fq & 1) ? 16 + 4 * (fq - 1) : 4 * fq);
                    bf16_t* dst = O + (size_t)row * ldc + u.pn * BM + wc * 64 + dd;
                    if (u.pn == 4) { const int s = row & 4095;
                        dst = KT + (((((size_t)((row >> 12) * 4 + wc) * 64 + (s >> 6)) * 8 + (dd >> 3)) * 64 + (s & 63)) * 8); }
                    *(u32x4*)dst = ww; }
            }
    }
};

template <bool GATE> struct EpiResid {
    static constexpr bool PERM = true, AFTER_DRAIN = false;
    const float* xin32; const bf16_t* rin; bf16_t* rout; const bf16_t* pp; const float* ssp_in; float* ssp_out;
    __device__ __forceinline__ void operator()(const f32x4 (&acc)[2][2][4][2], const Unit& u, int wr, int wc, int fr, int fq) const {
        asm volatile("" : "+v"(fr), "+v"(fq));
        const int row0 = u.pm * BM + wr * 64 + fr, col0 = u.pn * BM + wc * 32 + 8 * fq;
#pragma unroll
        for (int ai = 0; ai < 2; ++ai)
#pragma unroll
            for (int m = 0; m < 4; ++m) { const int row = row0 + ai * HALF + m * 16; const size_t off = (size_t)row * DMODEL + col0;
                float rs = 0.f; if (GATE) rs = row_rstd(ssp_in, row, fq);
                float sq = 0.f;
#pragma unroll
                for (int bj = 0; bj < 2; ++bj) { const size_t c = off + bj * HALF;
                    f32x4 xi0, xi1;
                    if (xin32) { xi0 = *(const f32x4*)(xin32 + c); xi1 = *(const f32x4*)(xin32 + c + 4); }
                    else { const u32x4 rw = *(const u32x4*)(rin + c);
                        xi0[0] = __uint_as_float(rw.x << 16); xi0[1] = __uint_as_float(rw.x & 0xffff0000u); xi0[2] = __uint_as_float(rw.y << 16); xi0[3] = __uint_as_float(rw.y & 0xffff0000u);
                        xi1[0] = __uint_as_float(rw.z << 16); xi1[1] = __uint_as_float(rw.z & 0xffff0000u); xi1[2] = __uint_as_float(rw.w << 16); xi1[3] = __uint_as_float(rw.w & 0xffff0000u); }
                    f32x4 a0 = acc[ai][bj][m][0], a1 = acc[ai][bj][m][1];
                    if (GATE) { const u32x4 pw = *(const u32x4*)(pp + c);
                        a0[0] = sigmoid_f(a0[0] * rs) * __uint_as_float(pw.x << 16); a0[1] = sigmoid_f(a0[1] * rs) * __uint_as_float(pw.x & 0xffff0000u);
                        a0[2] = sigmoid_f(a0[2] * rs) * __uint_as_float(pw.y << 16); a0[3] = sigmoid_f(a0[3] * rs) * __uint_as_float(pw.y & 0xffff0000u);
                        a1[0] = sigmoid_f(a1[0] * rs) * __uint_as_float(pw.z << 16); a1[1] = sigmoid_f(a1[1] * rs) * __uint_as_float(pw.z & 0xffff0000u);
                        a1[2] = sigmoid_f(a1[2] * rs) * __uint_as_float(pw.w << 16); a1[3] = sigmoid_f(a1[3] * rs) * __uint_as_float(pw.w & 0xffff0000u); }
                    const f32x4 xo0 = xi0 + a0, xo1 = xi1 + a1;
                    u32x4 w; w.x = cvt_pk_bf16(xo0[0], xo0[1]); w.y = cvt_pk_bf16(xo0[2], xo0[3]); w.z = cvt_pk_bf16(xo1[0], xo1[1]); w.w = cvt_pk_bf16(xo1[2], xo1[3]);
                    *(u32x4*)(rout + c) = w;
                    sq += ((xo0[0] * xo0[0] + xo0[1] * xo0[1]) + (xo0[2] * xo0[2] + xo0[3] * xo0[3])) + ((xo1[0] * xo1[0] + xo1[1] * xo1[1]) + (xo1[2] * xo1[2] + xo1[3] * xo1[3])); }
                sq += __shfl_xor(sq, 16); sq += __shfl_xor(sq, 32);
                if (fq == 0) ssp_out[(size_t)row * NSLOT_SS + u.pn * 4 + wc] = sq;
            }
    }
};

template <class Epi, class Sched, bool ALIGN_EPI = false, bool SP2 = false>
__device__ __forceinline__ void gemm_phase(PG8_LAS unsigned char* lds, const Gemm g, const Sched& S, const Epi& E) {
    int tid_ = threadIdx.x; asm volatile("" : "+v"(tid_));
    const int tid = tid_, wid = __builtin_amdgcn_readfirstlane(tid >> 6), lane = tid & 63, wr = wid >> 2, wc = wid & 3, fr = lane & 15, fq = lane >> 4;
    int K_ = g.K; asm volatile("" : "+s"(K_)); const int K = K_, nt = K / BK;
    unsigned voffA[2], voffB[2];
#pragma unroll
    for (int i = 0; i < 2; ++i) { int R, C; stage_rc(tid * 16 + i * 8192, R, C); const int Rb = Epi::PERM ? ((R & ~31) + perm32(R & 31)) : R;
        voffA[i] = (unsigned)(R * g.lda + C) * 2u; voffB[i] = (unsigned)(Rb * g.ldb + C) * 2u; }
    const size_t kstep = (size_t)(BK * 2);
    const size_t hsA = (size_t)HALF * g.lda * 2, hsB = (size_t)HALF * g.ldb * 2;
    const size_t tsA = 2 * hsA, tsB = 2 * hsB;
    const unsigned ldsw = (unsigned)wid * 1024u;
    const int aoff = lds_byte(wr * 64 + fr, fq * 8), boff = lds_byte(wc * 32 + fr, fq * 8);
#define PG8_SA(b, h) (((b) * 2 + (h)) * HTB)
#define PG8_SB(b, h) ((4 + (b) * 2 + (h)) * HTB)
#define PG8_STAGE(bufoff, gbase, voff) do { _Pragma("unroll") for (int _i = 0; _i < 2; ++_i) \
        __builtin_amdgcn_global_load_lds((const unsigned*)((const char*)(gbase) + (voff)[_i]), (PG8_LAS unsigned*)(lds + (bufoff) + ldsw + _i * 8192), 16, 0, 0); } while (0)
#define PG8_LDA(dst, b, h) do { _Pragma("unroll") for (int m = 0; m < 4; ++m) _Pragma("unroll") for (int k = 0; k < 2; ++k) dst[m][k] = *(const PG8_LAS bf16x8*)(lds + PG8_SA(b, h) + aoff + m * 2048 + k * 1024); } while (0)
#define PG8_LDB(dst, b, h) do { _Pragma("unroll") for (int n = 0; n < 2; ++n) _Pragma("unroll") for (int k = 0; k < 2; ++k) dst[n][k] = *(const PG8_LAS bf16x8*)(lds + PG8_SB(b, h) + boff + n * 2048 + k * 1024); } while (0)
#define PG8_MMA(ai, bj, At, Bt) do { __builtin_amdgcn_s_setprio(1); _Pragma("unroll") for (int m = 0; m < 4; ++m) _Pragma("unroll") for (int n = 0; n < 2; ++n) _Pragma("unroll") for (int k = 0; k < 2; ++k) \
        acc[ai][bj][m][n] = __builtin_amdgcn_mfma_f32_16x16x32_bf16(Bt[n][k], At[m][k], acc[ai][bj][m][n], 0, 0, 0); __builtin_amdgcn_s_setprio(0); } while (0)
#define PG8_WAIT_V(n) asm volatile("s_waitcnt vmcnt(" #n ")" ::: "memory")
#define PG8_WAIT_L(n) asm volatile("s_waitcnt lgkmcnt(" #n ")" ::: "memory")
#define PG8_BAR __builtin_amdgcn_s_barrier()
#define PG8_SCHED __builtin_amdgcn_sched_barrier(0)
    Unit cur, nxt; int ui = 0;
    if (!S.next(0, cur)) return;
    f32x4 acc[2][2][4][2];
#pragma unroll
    for (int a = 0; a < 2; ++a)
#pragma unroll
        for (int b = 0; b < 2; ++b)
#pragma unroll
            for (int m = 0; m < 4; ++m)
#pragma unroll
                for (int n = 0; n < 2; ++n) acc[a][b][m][n] = (f32x4){0.f, 0.f, 0.f, 0.f};
    bf16x8 At[4][2], B0[2][2], B1[2][2];
    const char* cA = (const char*)g.A + (size_t)cur.pm * tsA; const char* cB = (const char*)g.Bt + (size_t)cur.pn * tsB;
    S.a_ready(cur);
    if constexpr (SP2) {
        PG8_STAGE(PG8_SB(0, 0), cB, voffB); PG8_STAGE(PG8_SB(0, 1), cB + hsB, voffB); PG8_STAGE(PG8_SA(0, 0), cA, voffA); PG8_STAGE(PG8_SA(0, 1), cA + hsA, voffA);
        if (wr == 1) PG8_BAR;
        PG8_WAIT_V(2); PG8_BAR;
        PG8_STAGE(PG8_SB(1, 0), cB + kstep, voffB); PG8_STAGE(PG8_SA(1, 0), cA + kstep, voffA); PG8_STAGE(PG8_SB(1, 1), cB + hsB + kstep, voffB);
        PG8_WAIT_V(6); PG8_BAR;
    } else {
        PG8_STAGE(PG8_SB(0, 0), cB, voffB); PG8_STAGE(PG8_SA(0, 0), cA, voffA); PG8_STAGE(PG8_SB(0, 1), cB + hsB, voffB); PG8_STAGE(PG8_SA(0, 1), cA + hsA, voffA);
        if (wr == 1) PG8_BAR;
        PG8_WAIT_V(4); PG8_BAR;
        PG8_STAGE(PG8_SB(1, 0), cB + kstep, voffB); PG8_STAGE(PG8_SA(1, 0), cA + kstep, voffA); PG8_STAGE(PG8_SB(1, 1), cB + hsB + kstep, voffB);
        PG8_WAIT_V(6); PG8_BAR;
    }
    for (;;) {
        const bool has_next = S.next(ui + 1, nxt);
        const char* nA = has_next ? (const char*)g.A + (size_t)nxt.pm * tsA : cA; const char* nB = has_next ? (const char*)g.Bt + (size_t)nxt.pn * tsB : cB;
        for (int t = 0; t < nt; t += 2) {
            const bool last = (t == nt - 2);
            const char* a1 = cA + (size_t)(t + 1) * kstep;
            const char* a2 = last ? nA : cA + (size_t)(t + 2) * kstep; const char* b2 = last ? nB : cB + (size_t)(t + 2) * kstep;
            const char* a3 = a2 + kstep; const char* b3 = b2 + kstep;
            if (last && has_next) S.a_ready(nxt);
            if constexpr (SP2) {
            PG8_LDB(B0, 0, 0); PG8_LDB(B1, 0, 1); PG8_SCHED; PG8_LDA(At, 0, 0); PG8_STAGE(PG8_SA(1, 1), a1 + hsA, voffA);
            PG8_WAIT_V(8); PG8_WAIT_L(0); PG8_BAR; PG8_MMA(0, 0, At, B0); PG8_MMA(0, 1, At, B1); PG8_BAR; PG8_SCHED;
            PG8_LDA(At, 0, 1); PG8_STAGE(PG8_SB(0, 0), b2, voffB); PG8_STAGE(PG8_SB(0, 1), b2 + hsB, voffB); PG8_STAGE(PG8_SA(0, 0), a2, voffA);
            PG8_WAIT_V(8); PG8_WAIT_L(0); PG8_BAR; PG8_MMA(1, 0, At, B0); PG8_MMA(1, 1, At, B1); PG8_BAR; PG8_SCHED;
            PG8_LDB(B0, 1, 0); PG8_LDB(B1, 1, 1); PG8_SCHED; PG8_LDA(At, 1, 0); PG8_STAGE(PG8_SA(0, 1), a2 + hsA, voffA);
            PG8_WAIT_V(8); PG8_WAIT_L(0); PG8_BAR; PG8_MMA(0, 0, At, B0); PG8_MMA(0, 1, At, B1); PG8_BAR; PG8_SCHED;
            PG8_LDA(At, 1, 1); PG8_STAGE(PG8_SB(1, 0), b3, voffB); PG8_STAGE(PG8_SB(1, 1), b3 + hsB, voffB); PG8_STAGE(PG8_SA(1, 0), a3, voffA);
            PG8_WAIT_V(8); PG8_WAIT_L(0); PG8_BAR; PG8_MMA(1, 0, At, B0); PG8_MMA(1, 1, At, B1); PG8_BAR; PG8_SCHED;
            } else {
            PG8_LDB(B0, 0, 0); PG8_SCHED; PG8_LDA(At, 0, 0); PG8_STAGE(PG8_SA(1, 1), a1 + hsA, voffA);
            PG8_WAIT_L(8); PG8_BAR; PG8_WAIT_L(0); PG8_MMA(0, 0, At, B0); PG8_BAR; PG8_SCHED;
            PG8_LDB(B1, 0, 1); PG8_STAGE(PG8_SB(0, 0), b2, voffB);
            PG8_BAR; PG8_WAIT_L(0); PG8_MMA(0, 1, At, B1); PG8_BAR;
            PG8_LDA(At, 0, 1); PG8_STAGE(PG8_SA(0, 0), a2, voffA);
            PG8_BAR; PG8_WAIT_L(0); PG8_MMA(1, 0, At, B0); PG8_BAR; PG8_SCHED;
            PG8_STAGE(PG8_SB(0, 1), b2 + hsB, voffB);
            PG8_WAIT_V(6); PG8_BAR; PG8_MMA(1, 1, At, B1); PG8_BAR;
            PG8_LDB(B0, 1, 0); PG8_SCHED; PG8_LDA(At, 1, 0); PG8_STAGE(PG8_SA(0, 1), a2 + hsA, voffA);
            PG8_WAIT_L(8); PG8_BAR; PG8_WAIT_L(0); PG8_MMA(0, 0, At, B0); PG8_BAR; PG8_SCHED;
            PG8_LDB(B1, 1, 1); PG8_STAGE(PG8_SB(1, 0), b3, voffB);
            PG8_BAR; PG8_WAIT_L(0); PG8_MMA(0, 1, At, B1); PG8_BAR;
            PG8_LDA(At, 1, 1); PG8_STAGE(PG8_SA(1, 0), a3, voffA);
            PG8_BAR; PG8_WAIT_L(0); PG8_MMA(1, 0, At, B0); PG8_BAR; PG8_SCHED;
            PG8_STAGE(PG8_SB(1, 1), b3 + hsB, voffB);
            PG8_WAIT_V(6); PG8_BAR; PG8_MMA(1, 1, At, B1); PG8_BAR;
            }
        }
        if constexpr (ALIGN_EPI) { if (wr == 0) PG8_BAR; }
        if constexpr (!Epi::AFTER_DRAIN) { E(acc, cur, wr, wc, fr, fq); S.done(cur); }
        if (!has_next) break;
#pragma unroll
        for (int a = 0; a < 2; ++a)
#pragma unroll
            for (int b = 0; b < 2; ++b)
#pragma unroll
                for (int m = 0; m < 4; ++m)
#pragma unroll
                    for (int n = 0; n < 2; ++n) acc[a][b][m][n] = (f32x4){0.f, 0.f, 0.f, 0.f};
        cur = nxt; cA = nA; cB = nB; ++ui;
        if constexpr (ALIGN_EPI) { if (wr == 1) PG8_BAR; }
    }
    PG8_WAIT_V(0);
    if constexpr (!ALIGN_EPI) { if (wr == 0) PG8_BAR; }
    PG8_BAR;
    if constexpr (Epi::AFTER_DRAIN) { E.fused(acc, cur, wr, wc, fr, fq, lds, wid, lane); S.done(cur); }
#undef PG8_SA
#undef PG8_SB
#undef PG8_STAGE
#undef PG8_LDA
#undef PG8_LDB
#undef PG8_MMA
#undef PG8_WAIT_V
#undef PG8_WAIT_L
#undef PG8_BAR
#undef PG8_SCHED
}

}
namespace attn_body {
using bf16=__hip_bfloat16;
using bf16x8=__attribute__((ext_vector_type(8)))short;
using s16x4=__attribute__((ext_vector_type(4)))short;
using f32x16=__attribute__((ext_vector_type(16)))float;
using u32x4=__attribute__((ext_vector_type(4)))unsigned;
constexpr int BATCH=8,NHEAD=16,SEQ=4096,D=64,DM=2560,OPITCH=1024;
constexpr int NW=8,QBLK=32,QB=QBLK*NW,KVBLK=64,NQB=SEQ/QB;
constexpr int ATTN_PITCH=DM, ATTN_UNIT_ROWS=QB;
__device__ __forceinline__ int crow(int r,int hi){return (r&3)+8*(r>>2)+4*hi;}
#define SBAR() __builtin_amdgcn_sched_barrier(0)
__device__ __forceinline__ void cmask(f32x16&p0,f32x16&p1,int jb,int qrel,int hi){
  const float NEG=-INFINITY; int kb=64*jb+4*hi;
  #pragma unroll
  for(int r=0;r<16;++r){int kv=kb+(r&3)+8*(r>>2); if(kv>qrel)p0[r]=NEG; if(kv+32>qrel)p1[r]=NEG;}
}

constexpr int NSLOT=3, SLOTB=8192;
constexpr int LDS_K=0, LDS_V=NSLOT*SLOTB, LDS_WS=2*NSLOT*SLOTB, LDS_OST=LDS_WS+NW*64*4, LDS_BYTES=LDS_OST+NW*4096;
constexpr float C2=0.125f*1.4426950408889634f;
__device__ __forceinline__ void glds16(const void*gsrc,unsigned lds_dst){unsigned keep;
  asm volatile("s_mov_b32 %0, m0\n\ts_mov_b32 m0, %2\n\ts_nop 0\n\tglobal_load_lds_dwordx4 %1, off\n\ts_mov_b32 m0, %0":"=&s"(keep):"v"(gsrc),"s"(lds_dst):"memory");}
__device__ __forceinline__ float max3f(float a,float b,float c){float r;asm("v_max3_f32 %0, %1, %2, %3":"=v"(r):"v"(a),"v"(b),"v"(c));return r;}
__device__ __forceinline__ float max2f(float a,float b){float r;asm("v_max_f32_e32 %0, %1, %2":"=v"(r):"v"(a),"v"(b));return r;}
__device__ __forceinline__ float fadd_s(float a,float b){float r;asm("v_add_f32_e32 %0, %1, %2":"=v"(r):"v"(a),"v"(b));return r;}
__device__ __forceinline__ float fsub_s(float a,float b){float r;asm("v_sub_f32_e32 %0, %1, %2":"=v"(r):"v"(a),"v"(b));return r;}
typedef float f32x2_t __attribute__((ext_vector_type(2))); typedef __bf16 bf16x2_t __attribute__((ext_vector_type(2)));
__device__ __forceinline__ unsigned cvtpk_s(float lo,float hi){f32x2_t v={lo,hi};bf16x2_t b=__builtin_convertvector(v,bf16x2_t);return __builtin_bit_cast(unsigned,b);}
__device__ __forceinline__ float silu_f(float g){ return g*__builtin_amdgcn_rcpf(1.f+__builtin_amdgcn_exp2f(-1.4426950408889634f*g)); }
__device__ __forceinline__ unsigned gate_mul2(unsigned o,unsigned g){ const float o0=__uint_as_float(o<<16),o1=__uint_as_float(o&0xffff0000u),g0=__uint_as_float(g<<16),g1=__uint_as_float(g&0xffff0000u);
  return cvtpk_s(o0*silu_f(g0),o1*silu_f(g1)); }
#define WAIT_BAR(N) asm volatile("s_waitcnt vmcnt(" #N ") lgkmcnt(0)\n\ts_barrier":::"memory")

__device__ __forceinline__ void qkt(f32x16&p0,f32x16&p1,const char*Kslot,const bf16x8*qr,const f32x16&negm,int r32,int hi){
  const char*kb=Kslot+hi*1024+r32*16;
  #pragma unroll
  for(int d0=0;d0<4;++d0){
    const bf16x8 b0=*reinterpret_cast<const bf16x8*>(kb+d0*2048);
    const bf16x8 b1=*reinterpret_cast<const bf16x8*>(kb+d0*2048+512);
    if(d0==0){p0=__builtin_amdgcn_mfma_f32_32x32x16_bf16(b0,qr[0],negm,0,0,0);p1=__builtin_amdgcn_mfma_f32_32x32x16_bf16(b1,qr[0],negm,0,0,0);}
    else{p0=__builtin_amdgcn_mfma_f32_32x32x16_bf16(b0,qr[d0],p0,0,0,0);p1=__builtin_amdgcn_mfma_f32_32x32x16_bf16(b1,qr[d0],p1,0,0,0);}}
}
typedef __attribute__((address_space(3))) const char* lds_cptr;
typedef short v4i16_t __attribute__((ext_vector_type(4)));
__device__ __forceinline__ void kload8(bf16x8*kf,lds_cptr kp){
  kf[0]=*(const __attribute__((address_space(3))) bf16x8*)(kp);      kf[1]=*(const __attribute__((address_space(3))) bf16x8*)(kp+512);
  kf[2]=*(const __attribute__((address_space(3))) bf16x8*)(kp+2048); kf[3]=*(const __attribute__((address_space(3))) bf16x8*)(kp+2560);
  kf[4]=*(const __attribute__((address_space(3))) bf16x8*)(kp+4096); kf[5]=*(const __attribute__((address_space(3))) bf16x8*)(kp+4608);
  kf[6]=*(const __attribute__((address_space(3))) bf16x8*)(kp+6144); kf[7]=*(const __attribute__((address_space(3))) bf16x8*)(kp+6656);
}
__device__ __forceinline__ void kload2(bf16x8*kf,lds_cptr kp,int j){ kf[2*j]=*(const __attribute__((address_space(3))) bf16x8*)(kp+j*2048); kf[2*j+1]=*(const __attribute__((address_space(3))) bf16x8*)(kp+j*2048+512); }
__device__ __forceinline__ s16x4 vtr(lds_cptr p){ return __builtin_bit_cast(s16x4,__builtin_amdgcn_ds_read_tr16_b64_v4i16((__attribute__((address_space(3))) v4i16_t*)p)); }
__device__ __forceinline__ float rowmax(const f32x16&p0,const f32x16&p1){
  float a=max3f(p0[0],p0[1],p1[0]),b=max3f(p0[2],p0[3],p1[1]);a=max3f(a,p1[2],p1[3]);
  #pragma unroll
  for(int r=4;r<16;r+=4){a=max3f(a,p0[r],p0[r+1]);b=max3f(b,p0[r+2],p0[r+3]);a=max3f(a,p1[r],p1[r+1]);b=max3f(b,p1[r+2],p1[r+3]);}
  const float m=max2f(a,b);
  auto rr=__builtin_amdgcn_permlane32_swap(__float_as_uint(m),__float_as_uint(m),false,false);
  return max2f(__uint_as_float(rr[0]),__uint_as_float(rr[1]));
}
__device__ __forceinline__ void pv(f32x16*o,int vb,bf16x8 pa0,bf16x8 pa1,bf16x8 pa2,bf16x8 pa3){
  #pragma unroll
  for(int d0=0;d0<2;++d0){s16x4 lo[4],hi[4];
    #pragma unroll
    for(int ks=0;ks<4;++ks){
      asm volatile("ds_read_b64_tr_b16 %0,%1 offset:%c2":"=&v"(lo[ks]):"v"(vb),"i"(d0*4096+ks*1024):"memory");
      asm volatile("ds_read_b64_tr_b16 %0,%1 offset:%c2":"=&v"(hi[ks]):"v"(vb),"i"(d0*4096+ks*1024+512):"memory");}
    asm volatile("s_waitcnt lgkmcnt(0)":::"memory");SBAR();
    #define PK(k) (bf16x8){lo[k][0],lo[k][1],lo[k][2],lo[k][3],hi[k][0],hi[k][1],hi[k][2],hi[k][3]}
    o[d0]=__builtin_amdgcn_mfma_f32_32x32x16_bf16(pa0,PK(0),o[d0],0,0,0);
    o[d0]=__builtin_amdgcn_mfma_f32_32x32x16_bf16(pa1,PK(1),o[d0],0,0,0);
    o[d0]=__builtin_amdgcn_mfma_f32_32x32x16_bf16(pa2,PK(2),o[d0],0,0,0);
    o[d0]=__builtin_amdgcn_mfma_f32_32x32x16_bf16(pa3,PK(3),o[d0],0,0,0);
    #undef PK
  }
}

#ifndef ATTN_STORE16
#define ATTN_STORE16(p,v) (*(u32x4*)(p)=(v))
#endif
template<int THRL> __device__ __forceinline__ void attn_unit(int b,int h,int qb,const bf16*Q,const bf16* K,const bf16* V,const bf16* Gt,bf16*O,char*shm){
  int tid_=threadIdx.x; asm volatile("":"+v"(tid_)); const int tid=tid_,lane=tid&63,r32=lane&31,hi=lane>>5; const int wid=__builtin_amdgcn_readfirstlane(tid>>6);
  const long rowbase=(long)b*SEQ; const int q0=qb*QB;
  const bf16*Qw=Q+(rowbase+q0+wid*QBLK)*DM+h*D;
  const bf16*Kh=K+(long)(b*4+(h>>2))*64*4096,*Vh=V+(long)(b*4+(h>>2))*64*4096;
  const unsigned lds0=(unsigned)(uintptr_t)shm;
  float*wsf=(float*)(shm+LDS_WS)+wid*64;
  const bf16*ksrc=Kh+wid*512+lane*8;
  const bf16*vsrc=Vh+(wid>>2)*2048+(16*(wid&3)+(lane>>2))*32+(lane&3)*8;
  const unsigned kdst=lds0+LDS_K+wid*1024, vdst=lds0+LDS_V+wid*1024;
  #define DMA_K(t,slot) glds16(ksrc+(long)(t)*4096,(unsigned)__builtin_amdgcn_readfirstlane(kdst+(slot)))
  #define DMA_V(t,slot) glds16(vsrc+(long)(t)*4096,(unsigned)__builtin_amdgcn_readfirstlane(vdst+(slot)))
  const int vb0=(int)(lds0+LDS_V)+((lane>>4)&1)*32+(lane&3)*8+(4*hi+((lane&15)>>2))*64;
  const char*Kbase=shm+LDS_K; bf16x8 kf[8];
  const lds_cptr shm3=(lds_cptr)shm; const lds_cptr kp0=shm3+LDS_K+hi*1024+r32*16; const lds_cptr vp0=shm3+LDS_V+((lane>>4)&1)*32+(lane&3)*8+(4*hi+((lane&15)>>2))*64;
  const int NT=SEQ/KVBLK;
  DMA_K(0,0);DMA_V(0,0);DMA_K(1,SLOTB);
  bf16x8 qr[4];
  #pragma unroll
  for(int d0=0;d0<4;++d0)qr[d0]=*reinterpret_cast<const bf16x8*>(&Qw[(long)r32*DM+d0*16+hi*8]);
  float mhat=0.f,l_reg=0.f;f32x16 o[2];o[0]=f32x16{};o[1]=f32x16{};f32x16 negm=f32x16{};asm volatile("":"+v"(negm));
  const int qrel=wid*QBLK+r32;
  #define CMASK(P0,P1,t) do{}while(0)
  bool resc=false;
  #define START(P0,P1) do{ const float rm=rowmax(P0,P1); resc=false; \
    { const float dl=rm; mhat=fadd_s(mhat,dl); \
      _Pragma("unroll") for(int r=0;r<16;++r){P0[r]=fsub_s(P0[r],dl);P1[r]=fsub_s(P1[r],dl);} \
      _Pragma("unroll") for(int r=0;r<16;++r)negm[r]=-mhat; asm volatile("":"+v"(negm)); } \
    _Pragma("unroll") for(int r=0;r<16;++r)P0[r]=__builtin_amdgcn_exp2f(P0[r]); }while(0)
  #define RESC() do{ if(resc){ asm volatile("s_waitcnt lgkmcnt(0)":::"memory"); \
      _Pragma("unroll") for(int d_=0;d_<2;++d_) _Pragma("unroll") for(int r=0;r<16;++r)o[d_][r]*=wsf[crow(r,hi)]; } }while(0)
  f32x16 pA0,pA1,pB0,pB1;
  int sl_prev=0,sl_cur=0,sl_next=SLOTB;
  #define ROT() do{sl_prev=sl_cur;sl_cur=sl_next;sl_next=(sl_next==(NSLOT-1)*SLOTB)?0:sl_next+SLOTB;}while(0)
  DMA_K(2,2*SLOTB);
  WAIT_BAR(3);
  qkt(pA0,pA1,Kbase,qr,negm,r32,hi);asm volatile("s_nop 15\n\ts_nop 7":"+v"(pA0),"+v"(pA1));CMASK(pA0,pA1,0);
  START(pA0,pA1);
  _Pragma("unroll") for(int r=0;r<16;++r)pA1[r]=__builtin_amdgcn_exp2f(pA1[r]);
  WAIT_BAR(0);
  DMA_K(3,0);DMA_V(1,SLOTB);
  ROT();
  kload8(kf,kp0+sl_cur);
  WAIT_BAR(2);
  s16x4 vlo[8],vhi[8]; u32x4 pw0,pw1,pw2,pw3;
  #define PKW(P,B) cvtpk_s(P[B],P[B+1])
  #define PAF(k) __builtin_bit_cast(bf16x8,pw##k)
  #define VFR(i) (bf16x8){vlo[i][0],vlo[i][1],vlo[i][2],vlo[i][3],vhi[i][0],vhi[i][1],vhi[i][2],vhi[i][3]}
  #define PIN(x) asm volatile("":"+v"(x))
  #define MX3(a,b,c) __builtin_fmaxf(__builtin_fmaxf((a),(b)),(c))
  #define GAPA(MF,A0,A1,A2,A3,W0,W1,PW) do{ MF; sacc+=A0; sacc+=A1; sacc+=A2; sacc+=A3; PIN(sacc); W0; W1; PIN(PW); SBAR(); }while(0)
  #define EX(v) __builtin_amdgcn_exp2f(v)
  #define GAPB(MF,X,B) do{ MF; X[B]=EX(X[B]); X[B+1]=EX(X[B+1]); X[B+2]=EX(X[B+2]); X[B+3]=EX(X[B+3]); PIN(X); SBAR(); }while(0)
  #define VRD(i) do{ vlo[i]=vtr(vp_+(((i)>>2)*4096+((i)&3)*1024)); vhi[i]=vtr(vp_+(((i)>>2)*4096+((i)&3)*1024+512)); }while(0)
  #define KRD(G,j) do{ if(G){ kload2(kf,kp0+sl_next,j); SBAR(); } }while(0)
  #define STEP(C0,C1,P0,P1,t,GK,GV,GL) do{ SBAR(); \
    const lds_cptr vp_=vp0+sl_prev; \
    VRD(0); SBAR(); float sacc=(P0[0]+P0[1]); \
    GAPA(C0=__builtin_amdgcn_mfma_f32_32x32x16_bf16(kf[0],qr[0],negm,0,0,0), P0[2],P0[3],P0[4],P0[5],     pw0[0]=PKW(P0,0), pw0[1]=PKW(P0,2), pw0); \
    VRD(4); SBAR(); GAPA(C1=__builtin_amdgcn_mfma_f32_32x32x16_bf16(kf[1],qr[0],negm,0,0,0), P0[6],P0[7],P0[8],P0[9],     pw0[2]=PKW(P0,4), pw0[3]=PKW(P0,6), pw0); \
    VRD(1); SBAR(); GAPA(C0=__builtin_amdgcn_mfma_f32_32x32x16_bf16(kf[2],qr[1],C0,0,0,0),   P0[10],P0[11],P0[12],P0[13], pw1[0]=PKW(P0,8), pw1[1]=PKW(P0,10), pw1); \
    VRD(5); SBAR(); GAPA(C1=__builtin_amdgcn_mfma_f32_32x32x16_bf16(kf[3],qr[1],C1,0,0,0),   P0[14],P0[15],P1[0],P1[1],   pw1[2]=PKW(P0,12),pw1[3]=PKW(P0,14), pw1); \
    VRD(2); SBAR(); GAPA(C0=__builtin_amdgcn_mfma_f32_32x32x16_bf16(kf[4],qr[2],C0,0,0,0),   P1[2],P1[3],P1[4],P1[5],     pw2[0]=PKW(P1,0), pw2[1]=PKW(P1,2), pw2); \
    VRD(6); SBAR(); GAPA(C1=__builtin_amdgcn_mfma_f32_32x32x16_bf16(kf[5],qr[2],C1,0,0,0),   P1[6],P1[7],P1[8],P1[9],     pw2[2]=PKW(P1,4), pw2[3]=PKW(P1,6), pw2); \
    VRD(3); SBAR(); GAPA(C0=__builtin_amdgcn_mfma_f32_32x32x16_bf16(kf[6],qr[3],C0,0,0,0),   P1[10],P1[11],P1[12],P1[13], pw3[0]=PKW(P1,8), pw3[1]=PKW(P1,10), pw3); \
    VRD(7); SBAR(); GAPA(C1=__builtin_amdgcn_mfma_f32_32x32x16_bf16(kf[7],qr[3],C1,0,0,0),   P1[14],P1[15],0.f,0.f,       pw3[2]=PKW(P1,12),pw3[3]=PKW(P1,14), pw3); \
    l_reg+=sacc; \
    if(GK){DMA_K((t)+3,sl_cur);} if(GV){DMA_V((t)+1,sl_next);} \
    CMASK(C0,C1,t); \
    { float a=MX3(C0[0],C0[1],C1[0]),b=MX3(C0[2],C0[3],C1[1]); a=MX3(a,C1[2],C1[3]); \
      _Pragma("unroll") for(int r=4;r<16;r+=4){a=MX3(a,C0[r],C0[r+1]);b=MX3(b,C0[r+2],C0[r+3]);a=MX3(a,C1[r],C1[r+1]);b=MX3(b,C1[r+2],C1[r+3]);} \
      float rm=__builtin_fmaxf(a,b); { auto rr=__builtin_amdgcn_permlane32_swap(__float_as_uint(rm),__float_as_uint(rm),false,false); rm=__builtin_fmaxf(__uint_as_float(rr[0]),__uint_as_float(rr[1])); } \
      resc=false; \
      if(__builtin_expect(__any(rm>(float)THRL),0)){ const float dl=__builtin_fmaxf(rm,0.f); mhat+=dl; \
        _Pragma("unroll") for(int r=0;r<16;++r){C0[r]-=dl;C1[r]-=dl;} \
        _Pragma("unroll") for(int r=0;r<16;++r)negm[r]=-mhat; asm volatile("":"+v"(negm)); \
        const float f=__builtin_amdgcn_exp2f(-dl); l_reg*=f; if(hi==0)wsf[r32]=f; resc=true; } } \
    SBAR(); \
    GAPB(o[0]=__builtin_amdgcn_mfma_f32_32x32x16_bf16(PAF(0),VFR(0),o[0],0,0,0), C0,0); \
    GAPB(o[1]=__builtin_amdgcn_mfma_f32_32x32x16_bf16(PAF(0),VFR(4),o[1],0,0,0), C0,4); \
    KRD(GL,0); GAPB(o[0]=__builtin_amdgcn_mfma_f32_32x32x16_bf16(PAF(1),VFR(1),o[0],0,0,0), C0,8); \
    KRD(GL,1); GAPB(o[1]=__builtin_amdgcn_mfma_f32_32x32x16_bf16(PAF(1),VFR(5),o[1],0,0,0), C0,12); \
    KRD(GL,2); GAPB(o[0]=__builtin_amdgcn_mfma_f32_32x32x16_bf16(PAF(2),VFR(2),o[0],0,0,0), C1,0); \
    KRD(GL,3); GAPB(o[1]=__builtin_amdgcn_mfma_f32_32x32x16_bf16(PAF(2),VFR(6),o[1],0,0,0), C1,4); \
    GAPB(o[0]=__builtin_amdgcn_mfma_f32_32x32x16_bf16(PAF(3),VFR(3),o[0],0,0,0), C1,8); \
    GAPB(o[1]=__builtin_amdgcn_mfma_f32_32x32x16_bf16(PAF(3),VFR(7),o[1],0,0,0), C1,12); \
    }while(0)
  int t=1;
  #undef CMASK
  #define CMASK(P0,P1,t) do{}while(0)
  for(;t+5<NT;t+=2){
    STEP(pB0,pB1,pA0,pA1,t,true,true,true);     WAIT_BAR(2); RESC(); ROT();
    STEP(pA0,pA1,pB0,pB1,t+1,true,true,true);   WAIT_BAR(2); RESC(); ROT();
  }
  #undef CMASK
  #define CMASK(P0,P1,t) do{}while(0)
  #define ENDW(tt) do{ if((tt)+3<NT){WAIT_BAR(2);} else if((tt)+2<NT){WAIT_BAR(1);} else {WAIT_BAR(0);} }while(0)
  for(;t+1<NT;t+=2){
    STEP(pB0,pB1,pA0,pA1,t,(t+3<NT),(t+1<NT),(t+1<NT));       ENDW(t);   RESC(); ROT();
    STEP(pA0,pA1,pB0,pB1,t+1,(t+4<NT),(t+2<NT),(t+2<NT));     ENDW(t+1); RESC(); ROT();
  }
  const bf16*Gw=Gt+(rowbase+q0+wid*QBLK)*DM+h*D; u32x4 gpre[4];
  _Pragma("unroll") for(int i=0;i<4;++i) gpre[i]=*(const u32x4*)(Gw+(long)(i*8+(lane>>3))*DM+(lane&7)*8);
  STEP(pB0,pB1,pA0,pA1,NT-1,false,false,false); RESC();
  { float sacc=pB0[0]+pB0[1]; _Pragma("unroll") for(int r=2;r<16;++r)sacc+=pB0[r]; _Pragma("unroll") for(int r=0;r<16;++r)sacc+=pB1[r]; l_reg+=sacc;
    pw0=(u32x4){PKW(pB0,0),PKW(pB0,2),PKW(pB0,4),PKW(pB0,6)};pw1=(u32x4){PKW(pB0,8),PKW(pB0,10),PKW(pB0,12),PKW(pB0,14)};pw2=(u32x4){PKW(pB1,0),PKW(pB1,2),PKW(pB1,4),PKW(pB1,6)};pw3=(u32x4){PKW(pB1,8),PKW(pB1,10),PKW(pB1,12),PKW(pB1,14)};
    SBAR(); pv(o,vb0+sl_cur,PAF(0),PAF(1),PAF(2),PAF(3)); }
  #undef PKW
  #undef PAF
  #undef VFR
  #undef PIN
  #undef MX3
  #undef GAPA
  #undef GAPB
  #undef EX
  #undef VRD
  #undef KRD
  #undef STEP
  #undef ENDW
  {auto rr=__builtin_amdgcn_permlane32_swap(__float_as_uint(l_reg),__float_as_uint(l_reg),false,false);l_reg=__uint_as_float(rr[0])+__uint_as_float(rr[1]);}
  if(hi==0)wsf[32+r32]=l_reg;asm volatile("s_waitcnt lgkmcnt(0)":::"memory");
  float rli[16];
  #pragma unroll
  for(int r=0;r<16;++r)rli[r]=__builtin_amdgcn_rcpf(wsf[32+crow(r,hi)]);
  bf16*Ow=O+(rowbase+q0+wid*QBLK)*OPITCH+h*D;
  { bf16*stg=(bf16*)(shm+LDS_OST)+wid*2048;
    #pragma unroll
    for(int r=0;r<16;++r){const int orow=crow(r,hi);
      #pragma unroll
      for(int d0=0;d0<2;++d0)stg[orow*64+d0*32+r32]=__float2bfloat16(o[d0][r]*rli[r]);}
    asm volatile("s_waitcnt lgkmcnt(0)":::"memory");
    #pragma unroll
    for(int i=0;i<4;++i){const int row=i*8+(lane>>3),ch=lane&7; u32x4 v=*(const u32x4*)(stg+row*64+ch*8); const u32x4 gv=gpre[i]; v[0]=gate_mul2(v[0],gv[0]); v[1]=gate_mul2(v[1],gv[1]); v[2]=gate_mul2(v[2],gv[2]); v[3]=gate_mul2(v[3],gv[3]); ATTN_STORE16(Ow+(long)row*OPITCH+ch*8,v);} }
  asm volatile("s_waitcnt lgkmcnt(0)\n\ts_barrier":::"memory");
  #undef DMA_K
  #undef DMA_V
  #undef CMASK
  #undef START
  #undef RESC
  #undef ROT
}
constexpr int ATTN_LDS_BYTES=LDS_BYTES;
template<int THRL=8> __device__ __forceinline__ void attn_phase(char*lds,const bf16*P,const bf16*KT,const bf16*VTt,bf16*Pout,int vcu){
  const int grp=vcu>>3,s=vcu&7,b=grp>>2,kvh=grp&3;
  if(__builtin_amdgcn_readfirstlane(threadIdx.x>>6)<4) __builtin_amdgcn_s_setprio(2);
  for(int i=0;i<8;++i){ const int u=s*8+i; attn_unit<THRL>(b,kvh*4+(u>>4),u&15,P,KT,VTt,P+1536,Pout,lds); }
  __builtin_amdgcn_s_setprio(0);
}
#undef SBAR
#undef WAIT_BAR
}

namespace cg = cooperative_groups;
#define GAS __attribute__((address_space(1)))
#define LAS __attribute__((address_space(3)))
typedef unsigned short bf16;
typedef unsigned v4u __attribute__((ext_vector_type(4)));
typedef unsigned v2u __attribute__((ext_vector_type(2)));
typedef float f32x4 __attribute__((ext_vector_type(4)));
typedef float f32x16 __attribute__((ext_vector_type(16)));
typedef short bf16x8 __attribute__((ext_vector_type(8)));
typedef short s16x4 __attribute__((ext_vector_type(4)));
#define LDS_WAIT() asm volatile("s_waitcnt lgkmcnt(0)" ::: "memory")

#ifndef REP_NAT
#define REP_NAT 1
#endif
#ifndef REP_ATT
#define REP_ATT 1
#endif
#ifndef REP_P1
#define REP_P1 1
#endif
#ifndef REP_SYNC
#define REP_SYNC 1
#endif
#ifndef REP_PP
#define REP_PP 1
#endif
#ifndef REP_VT
#define REP_VT 1
#endif
#ifndef REP_NATC
#define REP_NATC 1
#endif
#ifndef REP_P3L0
#define REP_P3L0 1
#endif
#ifndef REP_P0
#define REP_P0 1
#endif
#ifndef MK_PER_PHASE
#define MK_PER_PHASE 0
#endif
constexpr int NWAVES = 8;
constexpr int BATCH = 8, SEQ = 4096, D = 1024, DEPTH = 4, PLE = 256, GW = 64;
constexpr int T = BATCH * SEQ;
constexpr int NA = 3072, NB = 2560;
constexpr float C2 = 0.125f * 1.4426950408889634f;
constexpr float LOG2E = 1.4426950408889634f;

constexpr size_t MiB = 1u << 20;
constexpr size_t WS_BAR = 0, BAR_ZERO_BYTES = 16384;
constexpr size_t WS_ROPE = 1 * MiB;
constexpr size_t WS_W = 2 * MiB;
constexpr size_t W_AQKG = 0, W_AV = 12 * MiB, W_B = 16 * MiB, W_AO = 26 * MiB, W_BO = 30 * MiB, W_G = 34 * MiB, W_P = 42 * MiB;
constexpr size_t WS_SS = 46 * MiB;
constexpr size_t SS_STAGE = (size_t)T * 16 * 4;
constexpr size_t WS_PB = 64 * MiB;
constexpr size_t WS_U = 128 * MiB, WS_V = 192 * MiB;
constexpr size_t WS_PROJ = 256 * MiB;
constexpr size_t WS_VT = 448 * MiB;
constexpr size_t WS_END = 512 * MiB;

constexpr int RING_BYTES = 131072, LDS_BYTES = 147456;
constexpr int MISC_OFF = LDS_BYTES - 64;

__device__ __forceinline__ unsigned f2bf(float f) { unsigned u = __builtin_bit_cast(unsigned, f); return (u + 0x7fffu + ((u >> 16) & 1u)) >> 16; }
__device__ __forceinline__ unsigned pk2(float lo, float hi) { return f2bf(lo) | (f2bf(hi) << 16); }
__device__ __forceinline__ float wave_sum(float v) {
#pragma unroll
    for (int o = 1; o < 64; o <<= 1) v += __shfl_xor(v, o);
    return v;
}

__device__ __forceinline__ void tr_item(const float* W, int ldw, int k0, int n0, bf16* WT, int K, int drow0, const float* gk, LAS float* scr, int lane, bool p32 = false) {
#pragma unroll 16
    for (int i = 0; i < 32; ++i) { const int kk = 2 * i + (lane >> 5); float w = W[(size_t)(k0 + kk) * ldw + n0 + (lane & 31)]; if (gk) w *= gk[k0 + kk]; scr[kk * 33 + (lane & 31)] = w; }
    LDS_WAIT(); asm volatile("" ::: "memory");
    const int c = lane & 7;
#pragma unroll
    for (int j = 0; j < 4; ++j) { const int n = (lane >> 3) + 8 * j; const LAS float* s = scr + (8 * c) * 33 + n;
        v4u o; o.x = pk2(s[0 * 33], s[1 * 33]); o.y = pk2(s[2 * 33], s[3 * 33]); o.z = pk2(s[4 * 33], s[5 * 33]); o.w = pk2(s[6 * 33], s[7 * 33]);
        const int nd = p32 ? 16 * ((n >> 2) & 1) + 4 * (n >> 3) + (n & 3) : n;
        __builtin_nontemporal_store(o, (GAS v4u*)(WT + (size_t)(drow0 + nd) * K + k0 + 8 * c)); }
    LDS_WAIT(); asm volatile("" ::: "memory");
}

struct Args { const float* in[14]; float* out; unsigned char* ws; int ph_lo, ph_hi; };

__device__ __forceinline__ void p0_prologue(const Args& a, LAS unsigned char* lds, int vcu, int G, int wave) {
    int tid_ = threadIdx.x; asm volatile("" : "+v"(tid_)); const int lane = tid_ & 63;
    unsigned char* ws = a.ws;
    LAS float* scr = (LAS float*)(lds + wave * 16384);
    const int gw = vcu * NWAVES + wave, NGW = G * NWAVES;
    bf16* wbase = (bf16*)(ws + WS_W);
    const float* norm_g = a.in[2];
    constexpr int I0 = 4096, I1 = 2560, I2 = 1024, I3 = 1024, I4 = 2048, I5 = 512, NITEMS = I0 + I1 + I2 + I3 + I4 + I5;
#pragma unroll 1
    for (int pass = 0; pass < 2; ++pass) {
    if (((wave & 1) == 0) == (pass == 0)) {
    for (int it = gw; it < NITEMS; it += NGW) {
        int r = it;
        if (r < I0) { const int j = r / 2048; r %= 2048; const int kb = r / 128, n0 = 32 * (r % 128), sec = n0 >> 10;
            bf16* WT = (sec == 2) ? (bf16*)((unsigned char*)wbase + W_AV) + (size_t)j * 1024 * 1024 : (bf16*)((unsigned char*)wbase + W_AQKG) + (size_t)j * 3072 * 1024;
            const int drow0 = (sec == 2) ? n0 - 2048 : (sec == 3 ? n0 - 1024 : n0);
            tr_item(a.in[3] + (size_t)j * 1024 * 4096, 4096, 64 * kb, n0, WT, 1024, drow0, norm_g + (2 * j) * 1024, scr, lane); continue; }
        r -= I0;
        if (r < I1) { const int j = r / 1280; r %= 1280; const int kb = r / 80, n0 = 32 * (r % 80);
            const bool vg = n0 >= 1280;
            const int drow0 = vg ? n0 : (n0 & ~255) + 128 * ((n0 >> 5) & 1) + 32 * ((n0 >> 6) & 3);
            tr_item(a.in[6] + (size_t)j * 1024 * 2560, 2560, 64 * kb, n0, (bf16*)((unsigned char*)wbase + W_B) + (size_t)j * 2560 * 1024, 1024, drow0, norm_g + (2 * j + 1) * 1024, scr, lane, vg); continue; }
        r -= I1;
        if (r < I2) { const int j = r / 512; r %= 512; const int kb = r / 32, n0 = 32 * (r % 32);
            tr_item(a.in[5] + (size_t)j * 1024 * 1024, 1024, 64 * kb, n0, (bf16*)((unsigned char*)wbase + W_AO) + (size_t)j * 1024 * 1024, 1024, n0, nullptr, scr, lane); continue; }
        r -= I2;
        if (r < I3) { const int j = r / 512; r %= 512; const int kb = r / 32, n0 = 32 * (r % 32);
            tr_item(a.in[9] + (size_t)j * 1024 * 1024, 1024, 64 * kb, n0, (bf16*)((unsigned char*)wbase + W_BO) + (size_t)j * 1024 * 1024, 1024, n0, nullptr, scr, lane); continue; }
        r -= I3;
        if (r < I4) { const int i = r / 512; r %= 512; const int kb = r / 32, n0 = 32 * (r % 32);
            tr_item(a.in[11] + (size_t)i * 1024 * 1024, 1024, 64 * kb, n0, (bf16*)((unsigned char*)wbase + W_G) + (size_t)i * 1024 * 1024, 1024, n0, a.in[10] + i * 1024, scr, lane); continue; }
        r -= I4;
        { const int i = r / 128; r %= 128; const int kb = r / 32, n0 = 32 * (r % 32);
            tr_item(a.in[12] + (size_t)i * 256 * 1024, 1024, 64 * kb, n0, (bf16*)((unsigned char*)wbase + W_P) + (size_t)i * 1024 * 256, 256, n0, nullptr, scr, lane); }
    }
    } else {
    { const f32x4* src = (const f32x4*)a.in[1]; v4u* dst = (v4u*)(ws + WS_PB); const size_t n8 = (size_t)DEPTH * T * PLE / 8;
#pragma unroll 4
      for (size_t i = (size_t)gw * 64 + lane; i < n8; i += (size_t)NGW * 64) { const f32x4 v0 = __builtin_nontemporal_load(src + 2 * i), v1 = __builtin_nontemporal_load(src + 2 * i + 1);
          v4u o; o.x = pk2(v0[0], v0[1]); o.y = pk2(v0[2], v0[3]); o.z = pk2(v1[0], v1[1]); o.w = pk2(v1[2], v1[3]); __builtin_nontemporal_store(o, dst + i); } }
    { const float* x = a.in[0]; bf16* xb = (bf16*)(ws + WS_U); float* ss0 = (float*)(ws + WS_SS);
#pragma unroll 2
      for (int m = gw; m < T; m += NGW) { const f32x4* xr = (const f32x4*)(x + (size_t)m * D) + lane; f32x4 v[4]; float s = 0.f;
#pragma unroll
          for (int j = 0; j < 4; ++j) { v[j] = __builtin_nontemporal_load(xr + 64 * j); s += (v[j][0] * v[j][0] + v[j][1] * v[j][1]) + (v[j][2] * v[j][2] + v[j][3] * v[j][3]); }
          s = wave_sum(s);
          v2u* o8 = (v2u*)(xb + (size_t)m * D) + lane;
#pragma unroll
          for (int j = 0; j < 4; ++j) { v2u o; o.x = pk2(v[j][0], v[j][1]); o.y = pk2(v[j][2], v[j][3]); __builtin_nontemporal_store(o, o8 + 64 * j); }
          if (lane < 16) ss0[(size_t)m * 16 + lane] = (lane == 0) ? s : 0.f; } }
    } }
    { const int gid = gw * 64 + lane;
      if (gid < 1024) { const int pos = gid >> 4, j = gid & 15; double th = 1.0; for (int q = 0; q < j; ++q) th *= 0.56234132519034908;
          const double t2 = th * th; double sn = 0.0, cn = 0.0, ts = th, tc = 1.0;
          for (int q = 0; q < 12; ++q) { cn += tc; sn += ts; tc *= -t2 / ((2 * q + 1) * (2 * q + 2)); ts *= -t2 / ((2 * q + 2) * (2 * q + 3)); }
          double cr = 1.0, sr = 0.0; for (int q = 0; q < pos; ++q) { const double c1 = cr * cn - sr * sn, s1 = sr * cn + cr * sn; cr = c1; sr = s1; }
          float* rc = (float*)(ws + WS_ROPE); rc[gid] = (float)cr; rc[1024 + gid] = (float)sr; } }
}

constexpr int NAT_K = 0, NAT_KSLOT = 6144, NAT_V = 67584, NAT_VD = 1072, NAT_TAB = 136192;
__device__ __forceinline__ void natten_phase(LAS unsigned char* lds, const bf16* P, const bf16* VT, bf16* O, const float* rpb, int vcu, int G, int wave) {
    int tid_ = threadIdx.x; asm volatile("" : "+v"(tid_)); const int tid = tid_, lane = tid_ & 63;
    const int q = lane & 15, g = lane >> 4;
    if (wave < 4) __builtin_amdgcn_s_setprio(2);
    for (int wu = vcu; wu < 256; wu += G) {
        const int b = wu >> 5, h = (wu >> 1) & 15, half = wu & 1, kc0 = 16 * half;
        __syncthreads();
        { LAS float* tab = (LAS float*)(lds + NAT_TAB); if (tid < 465) tab[tid] = rpb[h * 465 + tid] * LOG2E; if (tid < 256) tab[512 + tid] = -INFINITY; }
        const unsigned char* kbase = (const unsigned char*)(P + ((size_t)T * 1024) + ((size_t)(b * 16 + h) * SEQ) * 64);
        const unsigned char* vbase = (const unsigned char*)(VT + ((size_t)(b * 16 + h) * 64) * 64 * 64);
        unsigned kg_[3], vg_[3], kl_[3], vl_[3]; int kri[3], vri[3];
#pragma unroll
        for (int k = 0; k < 3; ++k) { const int id = tid + 512 * k, ri = id / 384, rem = id - ri * 384;
            { const int col = rem >> 3, c = rem & 7; kri[k] = ri;
              kg_[k] = (unsigned)(((ri * 64 + kc0 + col) * 64 + 8 * c) * 2);
              kl_[k] = (unsigned)(NAT_K + col * 128 + ((c ^ ((col >> 1) & 7)) << 4)); }
            { const int d = rem / 6, ch = rem - 6 * d; vri[k] = ri;
              vg_[k] = (unsigned)((((ri * 64) + d) * 64 + kc0 + 8 * ch) * 2);
              vl_[k] = (unsigned)(NAT_V + d * NAT_VD + ch * 16); } }
        v4u kreg[3], vreg[3];
#define NAT_ISSUE(first, n) do { const unsigned char* kb_ = kbase + (size_t)(first) * 8192; const unsigned char* vb_ = vbase + (size_t)(first) * 8192; \
        _Pragma("unroll") for (int k = 0; k < 3; ++k) { if (kri[k] < (n)) kreg[k] = *(const v4u*)(kb_ + kg_[k]); if (vri[k] < (n)) vreg[k] = *(const v4u*)(vb_ + vg_[k]); } } while (0)
#define NAT_COMMIT(first, n) do { _Pragma("unroll") for (int k = 0; k < 3; ++k) { \
            if (kri[k] < (n)) { const int sl = ((first) + kri[k]) % 11; *(LAS v4u*)(lds + kl_[k] + sl * NAT_KSLOT) = kreg[k]; } \
            if (vri[k] < (n)) { const int sl = ((first) + vri[k]) % 11; *(LAS v4u*)(lds + vl_[k] + sl * 96) = vreg[k]; } } } while (0)
        NAT_ISSUE(0, 4); NAT_COMMIT(0, 4); NAT_ISSUE(4, 4); NAT_COMMIT(4, 4);
        __syncthreads();
        const int cg2 = wave & 1, c0 = 32 * half + 16 * cg2, wsx = (half ? 8 : 0) + 8 * cg2;
        const int cs = min(max(c0 + q - 8, 0), 48);
        const int vl0 = wsx + 4 * g + kc0 - cs;
        const int swz = ((wsx >> 1) + (q >> 1)) & 7;
        const unsigned kb0 = (unsigned)(NAT_K + (wsx + q) * 128), kb1 = kb0 + 2048u;
        const unsigned ko00 = (unsigned)(((0 + g) ^ swz) << 4), ko01 = (unsigned)(((4 + g) ^ swz) << 4);
        const unsigned vb = (unsigned)(NAT_V + q * NAT_VD + (wsx + 4 * g) * 2); unsigned vb2 = vb + 32u; asm volatile("" : "+v"(vb2));
        const size_t tokh0 = (size_t)(b * 16 + h) * SEQ + (wave >> 1) * 64 + c0 + q;
        const bf16* qptr = P + tokh0 * 64 + 8 * g; const bf16* gptr = P + ((size_t)T * 2048) + tokh0 * 64 + 4 * g;
        bf16x8 qn0 = *(const bf16x8*)(qptr), qn1 = *(const bf16x8*)(qptr + 32);
#pragma unroll 1
        for (int tt = 0; tt < 16 * REP_NATC; ++tt) {
            const int t = tt / REP_NATC; const bool lastrep = (tt % REP_NATC) == REP_NATC - 1;
            const int hi_t = min(max(4 * t + 6, 7), 63), hi_n = (t < 15) ? min(max(4 * t + 10, 7), 63) : hi_t, first = hi_t + 1, nn = lastrep ? hi_n - hi_t : 0;
            if (nn > 0) NAT_ISSUE(first, nn);
            const bf16x8 qf0 = qn0, qf1 = qn1;
            if (t < 15 && lastrep) { const size_t adv = (size_t)(t + 1) * 4 * 64 * 64; qn0 = *(const bf16x8*)(qptr + adv); qn1 = *(const bf16x8*)(qptr + adv + 32); }
            {
                const int r = 4 * t + (wave >> 1), rs = min(max(r - 4, 0), 56);
                const size_t tokq = (size_t)b * SEQ + r * 64 + c0 + q;
                const int s0 = rs % 11;
                const unsigned tb = (unsigned)(NAT_TAB + 4 * ((rs - r + 7) * 31 + kc0 + wsx + 4 * g - c0 - q + 15));
                unsigned a8[8];
#pragma unroll
                for (int j = 0; j < 8; ++j) { const int cb = j >> 2, i = j & 3; a8[j] = ((unsigned)(16 * cb + i + vl0) < 16u) ? tb + 4u * (unsigned)(16 * cb + i) : (unsigned)(NAT_TAB + 2048); }
                f32x4 p[16];
                bf16x8 kc[4], kn[4]; float mx = -1e30f;
#define NAT_LDK(dst, kr_) do { const int sl_ = (s0 + (kr_) >= 11) ? s0 + (kr_) - 11 : s0 + (kr_); const unsigned so_ = (unsigned)sl_ * NAT_KSLOT; \
                    dst[0] = *(const LAS bf16x8*)(lds + kb0 + so_ + ko00); dst[1] = *(const LAS bf16x8*)(lds + kb0 + so_ + ko01); \
                    dst[2] = *(const LAS bf16x8*)(lds + kb1 + so_ + ko00); dst[3] = *(const LAS bf16x8*)(lds + kb1 + so_ + ko01); } while (0)
#define NAT_LDB(kr_) do { _Pragma("unroll") for (int i = 0; i < 4; ++i) { p[2 * (kr_)][i] = *((const LAS float*)(lds + a8[i]) + (kr_) * 31); p[2 * (kr_) + 1][i] = *((const LAS float*)(lds + a8[4 + i]) + (kr_) * 31); } } while (0)
                NAT_LDK(kc, 0); NAT_LDB(0);
#pragma unroll
                for (int kr = 0; kr < 8; ++kr) {
                    if (kr < 7) { NAT_LDK(kn, kr + 1); NAT_LDB(kr + 1); }
                    __builtin_amdgcn_sched_barrier(0);
                    f32x4 a0 = p[2 * kr], a1 = p[2 * kr + 1];
                    a0 = __builtin_amdgcn_mfma_f32_16x16x32_bf16(kc[0], qf0, a0, 0, 0, 0); a1 = __builtin_amdgcn_mfma_f32_16x16x32_bf16(kc[2], qf0, a1, 0, 0, 0);
                    a0 = __builtin_amdgcn_mfma_f32_16x16x32_bf16(kc[1], qf1, a0, 0, 0, 0); a1 = __builtin_amdgcn_mfma_f32_16x16x32_bf16(kc[3], qf1, a1, 0, 0, 0);
                    if (kr > 0) {
                        mx = fmaxf(fmaxf(mx, fmaxf(p[2 * kr - 2][0], p[2 * kr - 2][1])), fmaxf(p[2 * kr - 2][2], p[2 * kr - 2][3]));
                        mx = fmaxf(fmaxf(mx, fmaxf(p[2 * kr - 1][0], p[2 * kr - 1][1])), fmaxf(p[2 * kr - 1][2], p[2 * kr - 1][3])); }
                    p[2 * kr] = a0; p[2 * kr + 1] = a1;
                    __builtin_amdgcn_sched_barrier(0);
#pragma unroll
                    for (int j = 0; j < 4; ++j) kc[j] = kn[j]; }
#undef NAT_LDK
#undef NAT_LDB
                mx = fmaxf(fmaxf(mx, fmaxf(p[14][0], p[14][1])), fmaxf(p[14][2], p[14][3]));
                mx = fmaxf(fmaxf(mx, fmaxf(p[15][0], p[15][1])), fmaxf(p[15][2], p[15][3]));
                mx = fmaxf(mx, __shfl_xor(mx, 16)); mx = fmaxf(mx, __shfl_xor(mx, 32));
                if (__builtin_expect(__any(fabsf(mx) > 64.f), 0)) {
#pragma unroll
                    for (int bk = 0; bk < 16; ++bk)
#pragma unroll
                        for (int i = 0; i < 4; ++i) p[bk][i] -= mx; }
                f32x4 o[4], osum = {0.f, 0.f, 0.f, 0.f};
                const bf16x8 ones = {(short)0x3F80, (short)0x3F80, (short)0x3F80, (short)0x3F80, (short)0x3F80, (short)0x3F80, (short)0x3F80, (short)0x3F80};
#pragma unroll
                for (int db = 0; db < 4; ++db) o[db] = (f32x4){0.f, 0.f, 0.f, 0.f};
                v2u gc[4];
#pragma unroll
                for (int db = 0; db < 4; ++db) gc[db] = *(const v2u*)(gptr + (size_t)t * 4 * 64 * 64 + 16 * db);
                s16x4 vc[8], vn[8];
#define NAT_LDV(dst, kr_) do { const int sl_ = (s0 + (kr_) >= 11) ? s0 + (kr_) - 11 : s0 + (kr_); const unsigned so_ = (unsigned)sl_ * 96u; \
                    _Pragma("unroll") for (int db = 0; db < 4; ++db) { dst[2 * db] = *(const LAS s16x4*)(lds + vb + so_ + db * (16 * NAT_VD)); dst[2 * db + 1] = *(const LAS s16x4*)(lds + vb2 + so_ + db * (16 * NAT_VD)); } } while (0)
                NAT_LDV(vc, 0);
#pragma unroll
                for (int kr = 0; kr < 8; ++kr) {
                    if (kr < 7) NAT_LDV(vn, kr + 1);
#pragma unroll
                    for (int i = 0; i < 4; ++i) { p[2 * kr][i] = __builtin_amdgcn_exp2f(p[2 * kr][i]); p[2 * kr + 1][i] = __builtin_amdgcn_exp2f(p[2 * kr + 1][i]); }
                    v4u pw; pw.x = attn_body::cvtpk_s(p[2 * kr][0], p[2 * kr][1]); pw.y = attn_body::cvtpk_s(p[2 * kr][2], p[2 * kr][3]);
                    pw.z = attn_body::cvtpk_s(p[2 * kr + 1][0], p[2 * kr + 1][1]); pw.w = attn_body::cvtpk_s(p[2 * kr + 1][2], p[2 * kr + 1][3]);
                    const bf16x8 pf = __builtin_bit_cast(bf16x8, pw);
                    __builtin_amdgcn_sched_barrier(0);
                    osum = __builtin_amdgcn_mfma_f32_16x16x32_bf16(ones, pf, osum, 0, 0, 0);
#pragma unroll
                    for (int db = 0; db < 4; ++db) { const bf16x8 va = __builtin_shufflevector(vc[2 * db], vc[2 * db + 1], 0, 1, 2, 3, 4, 5, 6, 7);
                        o[db] = __builtin_amdgcn_mfma_f32_16x16x32_bf16(va, pf, o[db], 0, 0, 0); }
                    __builtin_amdgcn_sched_barrier(0);
#pragma unroll
                    for (int j = 0; j < 8; ++j) vc[j] = vn[j]; }
#undef NAT_LDV
                const float inv = __builtin_amdgcn_rcpf(osum[0]);
                bf16* orow = O + tokq * D + h * 64;
                v2u wq[4];
#pragma unroll
                for (int db = 0; db < 4; ++db) { const v2u gv = gc[db];
                    const float g0 = __uint_as_float(gv.x << 16), g1 = __uint_as_float(gv.x & 0xffff0000u), g2 = __uint_as_float(gv.y << 16), g3 = __uint_as_float(gv.y & 0xffff0000u);
                    wq[db].x = attn_body::cvtpk_s(o[db][0] * inv * attn_body::silu_f(g0), o[db][1] * inv * attn_body::silu_f(g1));
                    wq[db].y = attn_body::cvtpk_s(o[db][2] * inv * attn_body::silu_f(g2), o[db][3] * inv * attn_body::silu_f(g3)); }
#pragma unroll
                for (int pr = 0; pr < 2; ++pr) { v2u wa = wq[2 * pr], wb = wq[2 * pr + 1];
                    { auto r0 = __builtin_amdgcn_permlane16_swap(wa.x, wb.x, false, false); wa.x = r0[0]; wb.x = r0[1];
                      auto r1 = __builtin_amdgcn_permlane16_swap(wa.y, wb.y, false, false); wa.y = r1[0]; wb.y = r1[1]; }
                    v4u ww; ww.x = wa.x; ww.y = wa.y; ww.z = wb.x; ww.w = wb.y;
                    const int d0 = (g & 1) ? 16 * (2 * pr + 1) + 4 * (g - 1) : 16 * (2 * pr) + 4 * g;
                    *(v4u*)(orow + d0) = ww; }
            }
            asm volatile("s_waitcnt lgkmcnt(0)\n\ts_barrier" ::: "memory");
            if (nn > 0) NAT_COMMIT(first, nn);
            asm volatile("s_waitcnt lgkmcnt(0)\n\ts_barrier" ::: "memory");
        }
#undef NAT_ISSUE
#undef NAT_COMMIT
    }
    __builtin_amdgcn_s_setprio(0);
}

__device__ __forceinline__ void final_norm(const bf16* r, float* out, const float* ssp, const float* g, int vcu, int G, int wave) {
    int tid_ = threadIdx.x; asm volatile("" : "+v"(tid_)); const int lane = tid_ & 63;
    const int gw = vcu * NWAVES + wave, NGW = G * NWAVES;
    f32x4 gv[4];
#pragma unroll
    for (int j = 0; j < 4; ++j) gv[j] = *((const f32x4*)g + 2 * lane + (j & 1) + 128 * (j >> 1));
    for (int m = gw; m < T; m += NGW) {
        float s = (lane < 16) ? ssp[(size_t)m * 16 + lane] : 0.f; s = wave_sum(s);
        const float rs = rsqrtf(s * (1.0f / D) + 1e-6f);
        const v4u* rr = (const v4u*)(r + (size_t)m * D) + lane; f32x4* xo = (f32x4*)(out + (size_t)m * D) + 2 * lane;
#pragma unroll
        for (int j2 = 0; j2 < 2; ++j2) { const v4u w = rr[64 * j2];
            f32x4 v0, v1; v0[0] = __uint_as_float(w.x << 16); v0[1] = __uint_as_float(w.x & 0xffff0000u); v0[2] = __uint_as_float(w.y << 16); v0[3] = __uint_as_float(w.y & 0xffff0000u);
            v1[0] = __uint_as_float(w.z << 16); v1[1] = __uint_as_float(w.z & 0xffff0000u); v1[2] = __uint_as_float(w.w << 16); v1[3] = __uint_as_float(w.w & 0xffff0000u);
            xo[128 * j2] = v0 * rs * gv[2 * j2]; xo[128 * j2 + 1] = v1 * rs * gv[2 * j2 + 1]; }
    }
}

typedef GAS unsigned gu32;
#define XB_TMO      128
#define XB_XCNT(j)  (256  + 64 * (j))
#define XB_XSUB(j)  (1280 + 64 * (j))
#define XB_XGEN(j)  (2304 + 64 * (j))
#define XB_TOP      3328
#define XB_TOPGEN   3392
#define XCD_BAR_WORDS 3456
#define XB_SPIN_CAP (1u << 18)

__device__ __forceinline__ unsigned xb_ld(unsigned* p)              { return __hip_atomic_load(p, __ATOMIC_RELAXED, __HIP_MEMORY_SCOPE_AGENT); }
__device__ __forceinline__ unsigned xb_add(unsigned* p, unsigned v) { return __hip_atomic_fetch_add(p, v, __ATOMIC_RELAXED, __HIP_MEMORY_SCOPE_AGENT); }
__device__ __forceinline__ unsigned xb_xcc_id() { return (unsigned)__builtin_amdgcn_s_getreg((3 << 11) | 20) & 0xFu; }
#define XB_SPIN(cond, bar) do { unsigned _sp = 0; while (cond) { __builtin_amdgcn_s_sleep(1); \
    if ((++_sp & 255u) == 0u) { if (xb_ld(&(bar)[XB_TMO])) break; if (_sp > XB_SPIN_CAP) { atomicAdd(&(bar)[XB_TMO], 1u); break; } } } } while (0)

struct XcdBarrier {
    unsigned* bar; unsigned x;
    volatile LAS unsigned* st;
};

__device__ __forceinline__ XcdBarrier xcd_barrier_post(unsigned* bar, volatile LAS unsigned* st) {
    XcdBarrier b; b.bar = bar; b.x = xb_xcc_id(); b.st = st;
    if (threadIdx.x == 0) (void)xb_add(&bar[XB_XCNT(b.x)], 1u);
    return b;
}
__device__ __forceinline__ void xcd_barrier_complete(unsigned* bar, unsigned x, unsigned& nloc, unsigned& nx) {
    const unsigned G = gridDim.x * gridDim.y * gridDim.z;
    unsigned sum, cnt, mine, sp = 0u;
    for (;;) {
        sum = 0u; cnt = 0u; mine = 0u;
#pragma unroll
        for (unsigned j = 0; j < 16; ++j) { const unsigned c = xb_ld(&bar[XB_XCNT(j)]); sum += c; cnt += (c > 0u) ? 1u : 0u; mine = (j == x) ? c : mine; }
        if (sum == G) break;
        __builtin_amdgcn_s_sleep(1);
        if ((++sp & 255u) == 0u) { if (xb_ld(&bar[XB_TMO])) break; if (sp > XB_SPIN_CAP) { atomicAdd(&bar[XB_TMO], 1u); break; } }
    }
    nloc = mine > 0u ? mine : 1u; nx = cnt > 0u ? cnt : 1u;
}

__device__ __forceinline__ void xcd_barrier(const XcdBarrier& b) {
    asm volatile("s_waitcnt vmcnt(0)" ::: "memory");
    __syncthreads();
    if (threadIdx.x == 0) {
        unsigned* bar = b.bar;
        __builtin_amdgcn_s_waitcnt(0);
        unsigned nloc = b.st[0], nx = b.st[1];
        if (nloc == 0u) { xcd_barrier_complete(bar, b.x, nloc, nx); b.st[0] = nloc; b.st[1] = nx; }
        const unsigned old = xb_add(&bar[XB_XSUB(b.x)], 1u);
        const unsigned gen = old / nloc;
        if (old + 1u == (gen + 1u) * nloc) {
            __builtin_amdgcn_fence(__ATOMIC_RELEASE, "agent");
            asm volatile("s_waitcnt vmcnt(0)" ::: "memory");
            const unsigned og = xb_add(&bar[XB_TOP], 1u);
            const unsigned tg = og / nx;
            if (og + 1u == (tg + 1u) * nx) xb_add(&bar[XB_TOPGEN], 1u);
            else XB_SPIN(xb_ld(&bar[XB_TOPGEN]) == tg, bar);
            __builtin_amdgcn_fence(__ATOMIC_ACQUIRE, "agent");
            xb_add(&bar[XB_XGEN(b.x)], 1u);
            asm volatile("s_waitcnt vmcnt(0)" ::: "memory");
        } else {
            XB_SPIN(xb_ld(&bar[XB_XGEN(b.x)]) == gen, bar);
            __builtin_amdgcn_fence(__ATOMIC_ACQUIRE, "agent");
            asm volatile("s_waitcnt vmcnt(0)" ::: "memory");
        }
    }
    __syncthreads();
}
constexpr int N_PHASES = 2 + 4 * DEPTH;
__global__ void __launch_bounds__(NWAVES * 64, 2) mk_fwd(Args args) {
    extern __shared__ __attribute__((aligned(16))) unsigned char lds[];
    LAS unsigned char* L = (LAS unsigned char*)lds;
    const int tid = threadIdx.x, lane = tid & 63, wave = __builtin_amdgcn_readfirstlane(tid >> 6);
    const int G = gridDim.x, bx = blockIdx.x, vcu = (G % 8 == 0) ? (bx % 8) * (G / 8) + bx / 8 : bx;
    unsigned char* ws = args.ws;
    const int lo = args.ph_lo, hi = args.ph_hi;
#define IN(k) (lo <= (k) && (k) < hi)
    if (tid < 2) ((volatile LAS unsigned*)(L + MISC_OFF))[tid] = 0u;
    __syncthreads();
    XcdBarrier xbar; xbar.bar = (unsigned*)(ws + WS_BAR); xbar.x = 0; xbar.st = (volatile LAS unsigned*)(L + MISC_OFF);
#if MK_PER_PHASE
    if (hi - lo > 1) xbar = xcd_barrier_post((unsigned*)(ws + WS_BAR), (volatile LAS unsigned*)(L + MISC_OFF));
#else
    if (IN(0) && bx == 0) for (int i = tid; i < (int)(BAR_ZERO_BYTES / 4); i += NWAVES * 64) ((unsigned*)(ws + WS_BAR))[i] = 0u;
#endif
#define SEAM(k) do { if (IN(k) && IN((k) + 1)) for (int rep_ = 0; rep_ < REP_SYNC; ++rep_) { if ((k) == 0) cg::this_grid().sync(); else xcd_barrier(xbar); } } while (0)
#ifndef SKIP_P0
    for (int rep = 0; rep < REP_P0; ++rep)
    if (IN(0)) p0_prologue(args, L, vcu, G, wave);
#endif
    SEAM(0);
#if !MK_PER_PHASE
    xbar = xcd_barrier_post((unsigned*)(ws + WS_BAR), (volatile LAS unsigned*)(L + MISC_OFF));
#endif
    bf16* OB = (bf16*)args.out;
    bf16* PROJ = (bf16*)(ws + WS_PROJ); bf16* VT = (bf16*)(ws + WS_VT);
    const float* ropec = (const float*)(ws + WS_ROPE); const float* ropes = ropec + 1024;
#pragma unroll 1
    for (int i = 0; i < DEPTH; ++i) {
        const int j = i >> 1; const bool isA = (i & 1) == 0; const int pb0 = 1 + 4 * i;
        bf16* XB = (bf16*)(ws + ((i & 1) ? WS_V : WS_U));
        bf16* PP = (bf16*)(ws + ((i & 1) ? WS_U : WS_V));
        const float* ss_in = (const float*)(ws + WS_SS + (size_t)(2 * i) * SS_STAGE);
        float* ss_mid = (float*)(ws + WS_SS + (size_t)(2 * i + 1) * SS_STAGE);
        float* ss_out = (float*)(ws + WS_SS + (size_t)(2 * i + 2) * SS_STAGE);
        const bf16* wb = (const bf16*)(ws + WS_W);
        for (int rep = 0; rep < REP_P1; ++rep)
        if (IN(pb0)) {
            const bool ppfirst = (bx & 1) != 0;
#pragma unroll 1
            for (int pass = 0; pass < 2; ++pass) {
            if ((pass == 0) != ppfirst) {
#ifndef SKIP_G1A
            if (isA) {
                { pg8::Gemm g{XB, (const bf16*)((const unsigned char*)wb + W_AQKG) + (size_t)j * 3072 * 1024, T, NA, D, D, D}; pg8::StaticOrder S; S.init(T, NA, G, bx);
                  pg8::EpiBf16S<1, true> E{PROJ, NA, ss_in, 1024, C2};
                  pg8::gemm_phase<pg8::EpiBf16S<1, true>, pg8::StaticOrder, true, true>(L, g, S, E); }
                for (int rvt = 0; rvt < REP_VT; ++rvt)
                { pg8::Gemm g{(const bf16*)((const unsigned char*)wb + W_AV) + (size_t)j * 1024 * 1024, XB, D, T, D, D, D}; pg8::StaticOrder S; S.init(D, T, G, bx);
                  pg8::EpiBf16S<2, true> E{VT, T, ss_in, 0, 1.f};
                  pg8::gemm_phase<pg8::EpiBf16S<2, true>, pg8::StaticOrder, true, true>(L, g, S, E); }
            }
#endif
#ifndef SKIP_G1B
            if (!isA) {
                pg8::Gemm g{XB, (const bf16*)((const unsigned char*)wb + W_B) + (size_t)j * 2560 * 1024, T, NB, D, D, D}; pg8::StaticOrder S; S.init(T, NB, G, bx);
                pg8::EpiQKRope E{PROJ, NB, ss_in, args.in[7] + j * 64, args.in[8] + j * 64, ropec, ropes, C2, VT, VT + (size_t)8 * 1024 * 1024};
                pg8::gemm_phase<pg8::EpiQKRope, pg8::StaticOrder, true, true>(L, g, S, E);
            }
#endif
            } else {
#ifndef SKIP_GPP
            for (int rpp = 0; rpp < REP_PP; ++rpp)
            { pg8::Gemm g{(const bf16*)(ws + WS_PB) + (size_t)i * T * PLE, (const bf16*)((const unsigned char*)wb + W_P) + (size_t)i * 1024 * 256, T, D, PLE, PLE, PLE}; pg8::StaticOrder S; S.init(T, D, G, bx);
              pg8::EpiBf16S<0> E{PP, D, nullptr, 0, 1.f};
              pg8::gemm_phase<pg8::EpiBf16S<0>, pg8::StaticOrder, true, true>(L, g, S, E); }
#endif
            } }
        }
        SEAM(pb0);
        if (IN(pb0 + 1)) {
#ifndef SKIP_NAT
            for (int rep = 0; rep < REP_NAT; ++rep)
            if (isA) natten_phase(L, PROJ, VT, OB, args.in[4] + (size_t)j * 16 * 465, vcu, G, wave);
#endif
#ifndef SKIP_ATT
            for (int rep = 0; rep < REP_ATT; ++rep)
            if (!isA) attn_body::attn_phase<8>((char*)lds, (const attn_body::bf16*)PROJ, (const attn_body::bf16*)VT, (const attn_body::bf16*)(VT + (size_t)8 * 1024 * 1024), (attn_body::bf16*)OB, vcu);
#endif
        }
        SEAM(pb0 + 1);
#ifndef SKIP_G3
        for (int rep = 0; rep < ((i == 0) ? REP_P3L0 : 1); ++rep)
        if (IN(pb0 + 2)) {
            const bf16* wo = (const bf16*)((const unsigned char*)wb + (isA ? W_AO : W_BO)) + (size_t)j * 1024 * 1024;
            pg8::Gemm g{OB, wo, T, D, D, D, D}; pg8::StaticOrder S; S.init(T, D, G, bx);
            pg8::EpiResid<false> E{i == 0 ? args.in[0] : nullptr, XB, XB, nullptr, nullptr, ss_mid};
            pg8::gemm_phase<pg8::EpiResid<false>, pg8::StaticOrder, true, true>(L, g, S, E);
        }
#endif
        SEAM(pb0 + 2);
#ifndef SKIP_G4
        if (IN(pb0 + 3)) {
            pg8::Gemm g{XB, (const bf16*)((const unsigned char*)wb + W_G) + (size_t)i * 1024 * 1024, T, D, D, D, D}; pg8::StaticOrder S; S.init(T, D, G, bx);
            pg8::EpiResid<true> E{nullptr, XB, PP, PP, ss_mid, ss_out};
            pg8::gemm_phase<pg8::EpiResid<true>, pg8::StaticOrder, true, true>(L, g, S, E);
        }
#endif
        SEAM(pb0 + 3);
    }
    if (IN(N_PHASES - 1)) final_norm((const bf16*)(ws + WS_U), args.out, (const float*)(ws + WS_SS + (size_t)8 * SS_STAGE), args.in[13], vcu, G, wave);
#undef IN
#undef SEAM
}

extern "C" void kernel_launch(void* const* d_in, const int* in_sizes, int n_in, void* d_out, int out_size, void* d_ws, size_t ws_size, hipStream_t stream) {
    static int grid = 0;
    if (grid == 0) {
        if (n_in != 14 || out_size != T * D || ws_size < WS_END) { fprintf(stderr, "kernel_launch: unexpected shapes: n_in %d out %d ws %zu (need %zu)\n", n_in, out_size, ws_size, (size_t)WS_END); grid = -1; return; }
        int dev = 0, cus = 0, per_cu = 0;
        hipGetDevice(&dev); hipDeviceGetAttribute(&cus, hipDeviceAttributeMultiprocessorCount, dev);
        if (hipFuncSetAttribute((const void*)mk_fwd, hipFuncAttributeMaxDynamicSharedMemorySize, LDS_BYTES) != hipSuccess) { fprintf(stderr, "kernel_launch: hipFuncSetAttribute failed\n"); grid = -1; return; }
        if (hipOccupancyMaxActiveBlocksPerMultiprocessor(&per_cu, (const void*)mk_fwd, NWAVES * 64, LDS_BYTES) != hipSuccess || per_cu < 1) { fprintf(stderr, "kernel_launch: occupancy query says %d\n", per_cu); per_cu = 1; }
        (void)hipGetLastError();
        grid = cus;
        fprintf(stderr, "kernel_launch: grid %d (occupancy query %d/CU), ws %zu\n", grid, per_cu, ws_size);
    }
    if (grid < 0) return;
#if MK_PER_PHASE
    if (hipMemsetAsync((char*)d_ws + WS_BAR, 0, BAR_ZERO_BYTES, stream) != hipSuccess) { fprintf(stderr, "kernel_launch: memset failed\n"); return; }
#endif
    Args a{};
    for (int i = 0; i < 14; ++i) a.in[i] = (const float*)d_in[i];
    a.out = (float*)d_out; a.ws = (unsigned char*)d_ws;
#if MK_PER_PHASE
    for (int ph = 0; ph < N_PHASES; ++ph) { a.ph_lo = ph; a.ph_hi = ph + 1; hipLaunchKernelGGL(mk_fwd, dim3(grid), dim3(NWAVES * 64), LDS_BYTES, stream, a); }
#else
    a.ph_lo = 0; a.ph_hi = N_PHASES;
    void* kargs[] = {&a};
    const hipError_t e = hipLaunchCooperativeKernel((const void*)mk_fwd, dim3(grid), dim3(NWAVES * 64), kargs, LDS_BYTES, stream);
    if (e != hipSuccess) fprintf(stderr, "kernel_launch: cooperative launch failed: %s (grid %d)\n", hipGetErrorString(e), grid);
#endif
}
```

```cpp
#include <hip/hip_runtime.h>
#include <hip/hip_cooperative_groups.h>
#include <hip/hip_bf16.h>
#include <cstdio>
#include <cstdint>
#include <cmath>
namespace pg8 {
#define PG8_LAS __attribute__((address_space(3)))
typedef unsigned short bf16_t;
typedef short bf16x8 __attribute__((ext_vector_type(8)));
typedef float f32x4 __attribute__((ext_vector_type(4)));
typedef unsigned u32x4 __attribute__((ext_vector_type(4)));
constexpr int BM = 256, BK = 64, HALF = 128, HTB = HALF * BK * 2  , STAGE_BYTES = 8 * HTB, NXCD = 8, WGM = 8;

__host__ __device__ __forceinline__ int lds_byte(int r, int c) { const int st = (r >> 4) * 2 + (c >> 5), rr = r & 15, cc = c & 31, ob = rr * 64 + cc * 2; return st * 1024 + (ob ^ (((ob >> 9) & 1) << 5)); }
__host__ __device__ __forceinline__ void stage_rc(int b, int& R, int& C) { const int st = b / 1024, sb = b % 1024, swz = sb ^ (((sb >> 9) & 1) << 5); R = (st >> 1) * 16 + swz / 64; C = (st & 1) * 32 + (swz % 64) / 2; }
__host__ __device__ __forceinline__ int perm32(int rho) { const int n = rho >> 4, i = rho & 15; return 8 * (i >> 2) + 4 * n + (i & 3); }

struct Unit { int pm, pn; };
struct Gemm { const bf16_t* A; const bf16_t* Bt; int M, N, K, lda, ldb; };

struct StaticOrder {
    int nM, nN, nwg, G, c;
    __host__ __device__ void init(int M, int N, int G_, int c_) { nM = M / BM; nN = N / BM; nwg = nM * nN; G = G_; c = c_; }
    __host__ __device__ bool next(int i, Unit& u) const {
        const long L = (long)i * G + c; if (L >= nwg) return false;
        int wgid = (int)L; { const int q = nwg / NXCD, r = nwg % NXCD, xcd = wgid % NXCD, off = wgid / NXCD; wgid = (xcd < r ? xcd * (q + 1) : r * (q + 1) + (xcd - r) * q) + off; }
        const int nig = WGM * nN, gid = wgid / nig, fm = gid * WGM, gsz = (nM - fm) < WGM ? (nM - fm) : WGM;
        u.pm = fm + ((wgid % nig) % gsz); u.pn = (wgid % nig) / gsz; return true;
    }
    __device__ __forceinline__ void a_ready(const Unit&) const {}
    __device__ __forceinline__ void done(const Unit&) const {}
};

__device__ __forceinline__ unsigned cvt_pk_bf16(float lo, float hi) { unsigned r; asm volatile("v_cvt_pk_bf16_f32 %0, %1, %2" : "=v"(r) : "v"(lo), "v"(hi)); return r; }
typedef unsigned u32x2 __attribute__((ext_vector_type(2)));
constexpr float NORM_EPS = 1e-6f;
constexpr int DMODEL = 1024, NSLOT_SS = 16;
__device__ __forceinline__ float row_rstd(const float* ssp, int row, int fq) {
    const f32x4 v = *(const f32x4*)(ssp + (size_t)row * NSLOT_SS + 4 * fq);
    float s = (v[0] + v[1]) + (v[2] + v[3]);
    s += __shfl_xor(s, 16); s += __shfl_xor(s, 32);
    return rsqrtf(s * (1.0f / DMODEL) + NORM_EPS);
}
__device__ __forceinline__ float sigmoid_f(float x) { return __builtin_amdgcn_rcpf(1.f + __builtin_amdgcn_exp2f(-1.4426950408889634f * x)); }

template <int MODE, bool HT = false> struct EpiBf16S {
    static constexpr bool PERM = true, AFTER_DRAIN = false;
    bf16_t* O; int ldc; const float* ssp; int q_cols; float scale0;
    __device__ __forceinline__ void operator()(const f32x4 (&acc)[2][2][4][2], const Unit& u, int wr, int wc, int fr, int fq) const {
        asm volatile("" : "+v"(fr), "+v"(fq));
        const int row0 = u.pm * BM + wr * 64 + fr, col0 = u.pn * BM + wc * 32 + 8 * fq;
        const float sc = (MODE == 1 && u.pn * BM < q_cols) ? scale0 : 1.f;
        float cs[2][8];
        if (MODE == 2) {
            const int cj = col0 + (fr >> 3) * HALF + (fr & 7);
            float s = 0.f;
#pragma unroll
            for (int k = 0; k < 4; ++k) { const f32x4 v = *(const f32x4*)(ssp + (size_t)cj * NSLOT_SS + 4 * k); s += (v[0] + v[1]) + (v[2] + v[3]); }
            const float r = rsqrtf(s * (1.0f / DMODEL) + NORM_EPS);
            const int lane = fq * 16 + fr;
#pragma unroll
            for (int bj = 0; bj < 2; ++bj)
#pragma unroll
                for (int e = 0; e < 8; ++e) cs[bj][e] = __shfl(r, (lane & 48) + bj * 8 + e);
        }
#pragma unroll
        for (int ai = 0; ai < 2; ++ai)
#pragma unroll
            for (int m = 0; m < 4; ++m) { const int row = row0 + ai * HALF + m * 16; bf16_t* rowp = O + (size_t)row * ldc + col0;
                float rs = sc; if (MODE == 1) rs *= row_rstd(ssp, row, fq);
#pragma unroll
                for (int bj = 0; bj < 2; ++bj) { f32x4 v0 = acc[ai][bj][m][0], v1 = acc[ai][bj][m][1];
                    bf16_t* dst = rowp + bj * HALF;
                    if (HT && MODE == 1) { const int c = col0 + bj * HALF; dst = O + ((size_t)(c >> 10) << 25) + ((size_t)(((row >> 12) << 4) + ((c >> 6) & 15)) * 4096 + (row & 4095)) * 64 + (c & 63); }
                    if (HT && MODE == 2) { const int c = col0 + bj * HALF; dst = O + ((((size_t)(((c >> 12) << 4) + (row >> 6)) * 64 + ((c >> 6) & 63)) * 64 + (row & 63)) * 64) + (c & 63); }
                    if (MODE == 2) { v0[0] *= cs[bj][0]; v0[1] *= cs[bj][1]; v0[2] *= cs[bj][2]; v0[3] *= cs[bj][3]; v1[0] *= cs[bj][4]; v1[1] *= cs[bj][5]; v1[2] *= cs[bj][6]; v1[3] *= cs[bj][7]; }
                    else if (MODE == 1) { v0 = v0 * rs; v1 = v1 * rs; }
                    u32x4 w; w.x = cvt_pk_bf16(v0[0], v0[1]); w.y = cvt_pk_bf16(v0[2], v0[3]); w.z = cvt_pk_bf16(v1[0], v1[1]); w.w = cvt_pk_bf16(v1[2], v1[3]);
                    *(u32x4*)dst = w; } }
    }
};

struct EpiQKRope {
    static constexpr bool PERM = false, AFTER_DRAIN = false;
    bf16_t* O; int ldc; const float* ssp; const float* qg; const float* kg; const float* ropec; const float* ropes; float c2;
    bf16_t* KT; bf16_t* VTt;
    __device__ __forceinline__ void operator()(const f32x4 (&acc)[2][2][4][2], const Unit& u, int wr, int wc, int fr, int fq) const {
        asm volatile("" : "+v"(fr), "+v"(fq));
        const int row0 = u.pm * BM + wr * 64 + fr, col0 = u.pn * BM + wc * 64 + 4 * fq;
        const bool qk = u.pn < 5;
        if (!qk) {
            const int colv = u.pn * BM + wc * 32 + 8 * fq;
#pragma unroll
            for (int ai = 0; ai < 2; ++ai)
#pragma unroll
                for (int m = 0; m < 4; ++m) { const int row = row0 + ai * HALF + m * 16; bf16_t* rowp = O + (size_t)row * ldc + colv;
                    const float rs = row_rstd(ssp, row, fq);
#pragma unroll
                    for (int bj = 0; bj < 2; ++bj) { const f32x4 v0 = acc[ai][bj][m][0] * rs, v1 = acc[ai][bj][m][1] * rs;
                        u32x4 w; w.x = cvt_pk_bf16(v0[0], v0[1]); w.y = cvt_pk_bf16(v0[2], v0[3]); w.z = cvt_pk_bf16(v1[0], v1[1]); w.w = cvt_pk_bf16(v1[2], v1[3]);
                        bf16_t* dst = rowp + bj * HALF;
                        if (u.pn == 5) { const int kvh = 2 * bj + (wc >> 1), s = row & 4095;
                            dst = VTt + ((((size_t)((row >> 12) * 4 + kvh) * 64 + (s >> 6)) * 2 + (wc & 1)) * 64 + (s & 63)) * 32 + 8 * fq; }
                        *(u32x4*)dst = w; } }
            return;
        }
        const float* gp = (u.pn < 4) ? qg : kg; const float osc = (u.pn < 4) ? c2 : 1.f;
#pragma unroll
        for (int ai = 0; ai < 2; ++ai)
#pragma unroll
            for (int m = 0; m < 4; ++m) { const int row = row0 + ai * HALF + m * 16; bf16_t* rowp = O + (size_t)row * ldc + col0;
                const float rs = row_rstd(ssp, row, fq);
                f32x4 v[2][2];
#pragma unroll
                for (int bj = 0; bj < 2; ++bj)
#pragma unroll
                    for (int n = 0; n < 2; ++n) v[bj][n] = acc[ai][bj][m][n] * rs;
                if (qk) {
                    const float* gp2 = gp; asm volatile("" : "+s"(gp2));
                    f32x4 gn[2][2];
#pragma unroll
                    for (int bj = 0; bj < 2; ++bj)
#pragma unroll
                        for (int n = 0; n < 2; ++n) gn[bj][n] = *(const f32x4*)(gp2 + 32 * bj + 16 * n + 4 * fq);
                    float sq = 0.f;
#pragma unroll
                    for (int bj = 0; bj < 2; ++bj)
#pragma unroll
                        for (int n = 0; n < 2; ++n) sq += (v[bj][n][0] * v[bj][n][0] + v[bj][n][1] * v[bj][n][1]) + (v[bj][n][2] * v[bj][n][2] + v[bj][n][3] * v[bj][n][3]);
                    sq += __shfl_xor(sq, 16); sq += __shfl_xor(sq, 32);
                    const float hr = rsqrtf(sq * (1.0f / 64.0f) + NORM_EPS);
                    const int t = row & 4095, prow = t >> 6, pcol = t & 63;
#pragma unroll
                    for (int bj = 0; bj < 2; ++bj) { const int pos = bj ? pcol : prow;
                        const f32x4 c = *(const f32x4*)(ropec + pos * 16 + 4 * fq), s = *(const f32x4*)(ropes + pos * 16 + 4 * fq);
                        const f32x4 x1 = v[bj][0] * hr * gn[bj][0], x2 = v[bj][1] * hr * gn[bj][1];
                        v[bj][0] = (x1 * c - x2 * s) * osc; v[bj][1] = (x2 * c + x1 * s) * osc; }
                }
#pragma unroll
                for (int bj = 0; bj < 2; ++bj) {
                    u32x2 w0, w1;
                    w0.x = cvt_pk_bf16(v[bj][0][0], v[bj][0][1]); w0.y = cvt_pk_bf16(v[bj][0][2], v[bj][0][3]);
                    w1.x = cvt_pk_bf16(v[bj][1][0], v[bj][1][1]); w1.y = cvt_pk_bf16(v[bj][1][2], v[bj][1][3]);
                    { auto r0 = __builtin_amdgcn_permlane16_swap(w0.x, w1.x, false, false); w0.x = r0[0]; w1.x = r0[1];
                      auto r1 = __builtin_amdgcn_permlane16_swap(w0.y, w1.y, false, false); w0.y = r1[0]; w1.y = r1[1]; }
                    u32x4 ww; ww.x = w0.x; ww.y = w0.y; ww.z = w1.x; ww.w = w1.y;
                    const int dd = 32 * bj + ((fq & 1) ? 16 + 4 * (fq - 1) : 4 * fq);
                    bf16_t* dst = O + (size_t)row * ldc + u.pn * BM + wc * 64 + dd;
                    if (u.pn == 4) { const int s = row & 4095;
                        dst = KT + (((((size_t)((row >> 12) * 4 + wc) * 64 + (s >> 6)) * 8 + (dd >> 3)) * 64 + (s & 63)) * 8); }
                    *(u32x4*)dst = ww; }
            }
    }
};

template <bool GATE> struct EpiResid {
    static constexpr bool PERM = true, AFTER_DRAIN = false;
    const float* xin32; const bf16_t* rin; bf16_t* rout; const bf16_t* pp; const float* ssp_in; float* ssp_out;
    __device__ __forceinline__ void operator()(const f32x4 (&acc)[2][2][4][2], const Unit& u, int wr, int wc, int fr, int fq) const {
        asm volatile("" : "+v"(fr), "+v"(fq));
        const int row0 = u.pm * BM + wr * 64 + fr, col0 = u.pn * BM + wc * 32 + 8 * fq;
#pragma unroll
        for (int ai = 0; ai < 2; ++ai)
#pragma unroll
            for (int m = 0; m < 4; ++m) { const int row = row0 + ai * HALF + m * 16; const size_t off = (size_t)row * DMODEL + col0;
                float rs = 0.f; if (GATE) rs = row_rstd(ssp_in, row, fq);
                float sq = 0.f;
#pragma unroll
                for (int bj = 0; bj < 2; ++bj) { const size_t c = off + bj * HALF;
                    f32x4 xi0, xi1;
                    if (xin32) { xi0 = *(const f32x4*)(xin32 + c); xi1 = *(const f32x4*)(xin32 + c + 4); }
                    else { const u32x4 rw = *(const u32x4*)(rin + c);
                        xi0[0] = __uint_as_float(rw.x << 16); xi0[1] = __uint_as_float(rw.x & 0xffff0000u); xi0[2] = __uint_as_float(rw.y << 16); xi0[3] = __uint_as_float(rw.y & 0xffff0000u);
                        xi1[0] = __uint_as_float(rw.z << 16); xi1[1] = __uint_as_float(rw.z & 0xffff0000u); xi1[2] = __uint_as_float(rw.w << 16); xi1[3] = __uint_as_float(rw.w & 0xffff0000u); }
                    f32x4 a0 = acc[ai][bj][m][0], a1 = acc[ai][bj][m][1];
                    if (GATE) { const u32x4 pw = *(const u32x4*)(pp + c);
                        a0[0] = sigmoid_f(a0[0] * rs) * __uint_as_float(pw.x << 16); a0[1] = sigmoid_f(a0[1] * rs) * __uint_as_float(pw.x & 0xffff0000u);
                        a0[2] = sigmoid_f(a0[2] * rs) * __uint_as_float(pw.y << 16); a0[3] = sigmoid_f(a0[3] * rs) * __uint_as_float(pw.y & 0xffff0000u);
                        a1[0] = sigmoid_f(a1[0] * rs) * __uint_as_float(pw.z << 16); a1[1] = sigmoid_f(a1[1] * rs) * __uint_as_float(pw.z & 0xffff0000u);
                        a1[2] = sigmoid_f(a1[2] * rs) * __uint_as_float(pw.w << 16); a1[3] = sigmoid_f(a1[3] * rs) * __uint_as_float(pw.w & 0xffff0000u); }
                    const f32x4 xo0 = xi0 + a0, xo1 = xi1 + a1;
                    u32x4 w; w.x = cvt_pk_bf16(xo0[0], xo0[1]); w.y = cvt_pk_bf16(xo0[2], xo0[3]); w.z = cvt_pk_bf16(xo1[0], xo1[1]); w.w = cvt_pk_bf16(xo1[2], xo1[3]);
                    *(u32x4*)(rout + c) = w;
                    sq += ((xo0[0] * xo0[0] + xo0[1] * xo0[1]) + (xo0[2] * xo0[2] + xo0[3] * xo0[3])) + ((xo1[0] * xo1[0] + xo1[1] * xo1[1]) + (xo1[2] * xo1[2] + xo1[3] * xo1[3])); }
                sq += __shfl_xor(sq, 16); sq += __shfl_xor(sq, 32);
                if (fq == 0) ssp_out[(size_t)row * NSLOT_SS + u.pn * 4 + wc] = sq;
            }
    }
};

template <class Epi, class Sched, bool ALIGN_EPI = false, bool SP2 = false>
__device__ __forceinline__ void gemm_phase(PG8_LAS unsigned char* lds, const Gemm g, const Sched& S, const Epi& E) {
    int tid_ = threadIdx.x; asm volatile("" : "+v"(tid_));
    const int tid = tid_, wid = __builtin_amdgcn_readfirstlane(tid >> 6), lane = tid & 63, wr = wid >> 2, wc = wid & 3, fr = lane & 15, fq = lane >> 4;
    int K_ = g.K; asm volatile("" : "+s"(K_)); const int K = K_, nt = K / BK;
    unsigned voffA[2], voffB[2];
#pragma unroll
    for (int i = 0; i < 2; ++i) { int R, C; stage_rc(tid * 16 + i * 8192, R, C); const int Rb = Epi::PERM ? ((R & ~31) + perm32(R & 31)) : R;
        voffA[i] = (unsigned)(R * g.lda + C) * 2u; voffB[i] = (unsigned)(Rb * g.ldb + C) * 2u; }
    const size_t kstep = (size_t)(BK * 2);
    const size_t hsA = (size_t)HALF * g.lda * 2, hsB = (size_t)HALF * g.ldb * 2;
    const size_t tsA = 2 * hsA, tsB = 2 * hsB;
    const unsigned ldsw = (unsigned)wid * 1024u;
    const int aoff = lds_byte(wr * 64 + fr, fq * 8), boff = lds_byte(wc * 32 + fr, fq * 8);
#define PG8_SA(b, h) (((b) * 2 + (h)) * HTB)
#define PG8_SB(b, h) ((4 + (b) * 2 + (h)) * HTB)
#define PG8_STAGE(bufoff, gbase, voff) do { _Pragma("unroll") for (int _i = 0; _i < 2; ++_i) \
        __builtin_amdgcn_global_load_lds((const unsigned*)((const char*)(gbase) + (voff)[_i]), (PG8_LAS unsigned*)(lds + (bufoff) + ldsw + _i * 8192), 16, 0, 0); } while (0)
#define PG8_LDA(dst, b, h) do { _Pragma("unroll") for (int m = 0; m < 4; ++m) _Pragma("unroll") for (int k = 0; k < 2; ++k) dst[m][k] = *(const PG8_LAS bf16x8*)(lds + PG8_SA(b, h) + aoff + m * 2048 + k * 1024); } while (0)
#define PG8_LDB(dst, b, h) do { _Pragma("unroll") for (int n = 0; n < 2; ++n) _Pragma("unroll") for (int k = 0; k < 2; ++k) dst[n][k] = *(const PG8_LAS bf16x8*)(lds + PG8_SB(b, h) + boff + n * 2048 + k * 1024); } while (0)
#define PG8_MMA(ai, bj, At, Bt) do { __builtin_amdgcn_s_setprio(1); _Pragma("unroll") for (int m = 0; m < 4; ++m) _Pragma("unroll") for (int n = 0; n < 2; ++n) _Pragma("unroll") for (int k = 0; k < 2; ++k) \
        acc[ai][bj][m][n] = __builtin_amdgcn_mfma_f32_16x16x32_bf16(Bt[n][k], At[m][k], acc[ai][bj][m][n], 0, 0, 0); __builtin_amdgcn_s_setprio(0); } while (0)
#define PG8_WAIT_V(n) asm volatile("s_waitcnt vmcnt(" #n ")" ::: "memory")
#define PG8_WAIT_L(n) asm volatile("s_waitcnt lgkmcnt(" #n ")" ::: "memory")
#define PG8_BAR __builtin_amdgcn_s_barrier()
#define PG8_SCHED __builtin_amdgcn_sched_barrier(0)
    Unit cur, nxt; int ui = 0;
    if (!S.next(0, cur)) return;
    f32x4 acc[2][2][4][2];
#pragma unroll
    for (int a = 0; a < 2; ++a)
#pragma unroll
        for (int b = 0; b < 2; ++b)
#pragma unroll
            for (int m = 0; m < 4; ++m)
#pragma unroll
                for (int n = 0; n < 2; ++n) acc[a][b][m][n] = (f32x4){0.f, 0.f, 0.f, 0.f};
    bf16x8 At[4][2], B0[2][2], B1[2][2];
    const char* cA = (const char*)g.A + (size_t)cur.pm * tsA; const char* cB = (const char*)g.Bt + (size_t)cur.pn * tsB;
    S.a_ready(cur);
    if constexpr (SP2) {
        PG8_STAGE(PG8_SB(0, 0), cB, voffB); PG8_STAGE(PG8_SB(0, 1), cB + hsB, voffB); PG8_STAGE(PG8_SA(0, 0), cA, voffA); PG8_STAGE(PG8_SA(0, 1), cA + hsA, voffA);
        if (wr == 1) PG8_BAR;
        PG8_WAIT_V(2); PG8_BAR;
        PG8_STAGE(PG8_SB(1, 0), cB + kstep, voffB); PG8_STAGE(PG8_SA(1, 0), cA + kstep, voffA); PG8_STAGE(PG8_SB(1, 1), cB + hsB + kstep, voffB);
        PG8_WAIT_V(6); PG8_BAR;
    } else {
        PG8_STAGE(PG8_SB(0, 0), cB, voffB); PG8_STAGE(PG8_SA(0, 0), cA, voffA); PG8_STAGE(PG8_SB(0, 1), cB + hsB, voffB); PG8_STAGE(PG8_SA(0, 1), cA + hsA, voffA);
        if (wr == 1) PG8_BAR;
        PG8_WAIT_V(4); PG8_BAR;
        PG8_STAGE(PG8_SB(1, 0), cB + kstep, voffB); PG8_STAGE(PG8_SA(1, 0), cA + kstep, voffA); PG8_STAGE(PG8_SB(1, 1), cB + hsB + kstep, voffB);
        PG8_WAIT_V(6); PG8_BAR;
    }
    for (;;) {
        const bool has_next = S.next(ui + 1, nxt);
        const char* nA = has_next ? (const char*)g.A + (size_t)nxt.pm * tsA : cA; const char* nB = has_next ? (const char*)g.Bt + (size_t)nxt.pn * tsB : cB;
        for (int t = 0; t < nt; t += 2) {
            const bool last = (t == nt - 2);
            const char* a1 = cA + (size_t)(t + 1) * kstep;
            const char* a2 = last ? nA : cA + (size_t)(t + 2) * kstep; const char* b2 = last ? nB : cB + (size_t)(t + 2) * kstep;
            const char* a3 = a2 + kstep; const char* b3 = b2 + kstep;
            if (last && has_next) S.a_ready(nxt);
            if constexpr (SP2) {
            PG8_LDB(B0, 0, 0); PG8_LDB(B1, 0, 1); PG8_SCHED; PG8_LDA(At, 0, 0); PG8_STAGE(PG8_SA(1, 1), a1 + hsA, voffA);
            PG8_WAIT_V(8); PG8_WAIT_L(0); PG8_BAR; PG8_MMA(0, 0, At, B0); PG8_MMA(0, 1, At, B1); PG8_BAR; PG8_SCHED;
            PG8_LDA(At, 0, 1); PG8_STAGE(PG8_SB(0, 0), b2, voffB); PG8_STAGE(PG8_SB(0, 1), b2 + hsB, voffB); PG8_STAGE(PG8_SA(0, 0), a2, voffA);
            PG8_WAIT_V(8); PG8_WAIT_L(0); PG8_BAR; PG8_MMA(1, 0, At, B0); PG8_MMA(1, 1, At, B1); PG8_BAR; PG8_SCHED;
            PG8_LDB(B0, 1, 0); PG8_LDB(B1, 1, 1); PG8_SCHED; PG8_LDA(At, 1, 0); PG8_STAGE(PG8_SA(0, 1), a2 + hsA, voffA);
            PG8_WAIT_V(8); PG8_WAIT_L(0); PG8_BAR; PG8_MMA(0, 0, At, B0); PG8_MMA(0, 1, At, B1); PG8_BAR; PG8_SCHED;
            PG8_LDA(At, 1, 1); PG8_STAGE(PG8_SB(1, 0), b3, voffB); PG8_STAGE(PG8_SB(1, 1), b3 + hsB, voffB); PG8_STAGE(PG8_SA(1, 0), a3, voffA);
            PG8_WAIT_V(8); PG8_WAIT_L(0); PG8_BAR; PG8_MMA(1, 0, At, B0); PG8_MMA(1, 1, At, B1); PG8_BAR; PG8_SCHED;
            } else {
            PG8_LDB(B0, 0, 0); PG8_SCHED; PG8_LDA(At, 0, 0); PG8_STAGE(PG8_SA(1, 1), a1 + hsA, voffA);
            PG8_WAIT_L(8); PG8_BAR; PG8_WAIT_L(0); PG8_MMA(0, 0, At, B0); PG8_BAR; PG8_SCHED;
            PG8_LDB(B1, 0, 1); PG8_STAGE(PG8_SB(0, 0), b2, voffB);
            PG8_BAR; PG8_WAIT_L(0); PG8_MMA(0, 1, At, B1); PG8_BAR;
            PG8_LDA(At, 0, 1); PG8_STAGE(PG8_SA(0, 0), a2, voffA);
            PG8_BAR; PG8_WAIT_L(0); PG8_MMA(1, 0, At, B0); PG8_BAR; PG8_SCHED;
            PG8_STAGE(PG8_SB(0, 1), b2 + hsB, voffB);
            PG8_WAIT_V(6); PG8_BAR; PG8_MMA(1, 1, At, B1); PG8_BAR;
            PG8_LDB(B0, 1, 0); PG8_SCHED; PG8_LDA(At, 1, 0); PG8_STAGE(PG8_SA(0, 1), a2 + hsA, voffA);
            PG8_WAIT_L(8); PG8_BAR; PG8_WAIT_L(0); PG8_MMA(0, 0, At, B0); PG8_BAR; PG8_SCHED;
            PG8_LDB(B1, 1, 1); PG8_STAGE(PG8_SB(1, 0), b3, voffB);
            PG8_BAR; PG8_WAIT_L(0); PG8_MMA(0, 1, At, B1); PG8_BAR;
            PG8_LDA(At, 1, 1); PG8_STAGE(PG8_SA(1, 0), a3, voffA);
            PG8_BAR; PG8_WAIT_L(0); PG8_MMA(1, 0, At, B0); PG8_BAR; PG8_SCHED;
            PG8_STAGE(PG8_SB(1, 1), b3 + hsB, voffB);
            PG8_WAIT_V(6); PG8_BAR; PG8_MMA(1, 1, At, B1); PG8_BAR;
            }
        }
        if constexpr (ALIGN_EPI) { if (wr == 0) PG8_BAR; }
        if constexpr (!Epi::AFTER_DRAIN) { E(acc, cur, wr, wc, fr, fq); S.done(cur); }
        if (!has_next) break;
#pragma unroll
        for (int a = 0; a < 2; ++a)
#pragma unroll
            for (int b = 0; b < 2; ++b)
#pragma unroll
                for (int m = 0; m < 4; ++m)
#pragma unroll
                    for (int n = 0; n < 2; ++n) acc[a][b][m][n] = (f32x4){0.f, 0.f, 0.f, 0.f};
        cur = nxt; cA = nA; cB = nB; ++ui;
        if constexpr (ALIGN_EPI) { if (wr == 1) PG8_BAR; }
    }
    PG8_WAIT_V(0);
    if constexpr (!ALIGN_EPI) { if (wr == 0) PG8_BAR; }
    PG8_BAR;
    if constexpr (Epi::AFTER_DRAIN) { E.fused(acc, cur, wr, wc, fr, fq, lds, wid, lane); S.done(cur); }
#undef PG8_SA
#undef PG8_SB
#undef PG8_STAGE
#undef PG8_LDA
#undef PG8_LDB
#undef PG8_MMA
#undef PG8_WAIT_V
#undef PG8_WAIT_L
#undef PG8_BAR
#undef PG8_SCHED
}

}
namespace attn_body {
using bf16=__hip_bfloat16;
using bf16x8=__attribute__((ext_vector_type(8)))short;
using s16x4=__attribute__((ext_vector_type(4)))short;
using f32x16=__attribute__((ext_vector_type(16)))float;
using u32x4=__attribute__((ext_vector_type(4)))unsigned;
constexpr int BATCH=8,NHEAD=16,SEQ=4096,D=64,DM=2560,OPITCH=1024;
constexpr int NW=8,QBLK=32,QB=QBLK*NW,KVBLK=64,NQB=SEQ/QB;
constexpr int ATTN_PITCH=DM, ATTN_UNIT_ROWS=QB;
__device__ __forceinline__ int crow(int r,int hi){return (r&3)+8*(r>>2)+4*hi;}
#define SBAR() __builtin_amdgcn_sched_barrier(0)
__device__ __forceinline__ void cmask(f32x16&p0,f32x16&p1,int jb,int qrel,int hi){
  const float NEG=-INFINITY; int kb=64*jb+4*hi;
  #pragma unroll
  for(int r=0;r<16;++r){int kv=kb+(r&3)+8*(r>>2); if(kv>qrel)p0[r]=NEG; if(kv+32>qrel)p1[r]=NEG;}
}

constexpr int NSLOT=3, SLOTB=8192;
constexpr int LDS_K=0, LDS_V=NSLOT*SLOTB, LDS_WS=2*NSLOT*SLOTB, LDS_OST=LDS_WS+NW*64*4, LDS_BYTES=LDS_OST+NW*4096;
constexpr float C2=0.125f*1.4426950408889634f;
__device__ __forceinline__ void glds16(const void*gsrc,unsigned lds_dst){unsigned keep;
  asm volatile("s_mov_b32 %0, m0\n\ts_mov_b32 m0, %2\n\ts_nop 0\n\tglobal_load_lds_dwordx4 %1, off\n\ts_mov_b32 m0, %0":"=&s"(keep):"v"(gsrc),"s"(lds_dst):"memory");}
__device__ __forceinline__ float max3f(float a,float b,float c){float r;asm("v_max3_f32 %0, %1, %2, %3":"=v"(r):"v"(a),"v"(b),"v"(c));return r;}
__device__ __forceinline__ float max2f(float a,float b){float r;asm("v_max_f32_e32 %0, %1, %2":"=v"(r):"v"(a),"v"(b));return r;}
__device__ __forceinline__ float fadd_s(float a,float b){float r;asm("v_add_f32_e32 %0, %1, %2":"=v"(r):"v"(a),"v"(b));return r;}
__device__ __forceinline__ float fsub_s(float a,float b){float r;asm("v_sub_f32_e32 %0, %1, %2":"=v"(r):"v"(a),"v"(b));return r;}
typedef float f32x2_t __attribute__((ext_vector_type(2))); typedef __bf16 bf16x2_t __attribute__((ext_vector_type(2)));
__device__ __forceinline__ unsigned cvtpk_s(float lo,float hi){f32x2_t v={lo,hi};bf16x2_t b=__builtin_convertvector(v,bf16x2_t);return __builtin_bit_cast(unsigned,b);}
__device__ __forceinline__ float silu_f(float g){ return g*__builtin_amdgcn_rcpf(1.f+__builtin_amdgcn_exp2f(-1.4426950408889634f*g)); }
__device__ __forceinline__ unsigned gate_mul2(unsigned o,unsigned g){ const float o0=__uint_as_float(o<<16),o1=__uint_as_float(o&0xffff0000u),g0=__uint_as_float(g<<16),g1=__uint_as_float(g&0xffff0000u);
  return cvtpk_s(o0*silu_f(g0),o1*silu_f(g1)); }
#define WAIT_BAR(N) asm volatile("s_waitcnt vmcnt(" #N ") lgkmcnt(0)\n\ts_barrier":::"memory")

__device__ __forceinline__ void qkt(f32x16&p0,f32x16&p1,const char*Kslot,const bf16x8*qr,const f32x16&negm,int r32,int hi){
  const char*kb=Kslot+hi*1024+r32*16;
  #pragma unroll
  for(int d0=0;d0<4;++d0){
    const bf16x8 b0=*reinterpret_cast<const bf16x8*>(kb+d0*2048);
    const bf16x8 b1=*reinterpret_cast<const bf16x8*>(kb+d0*2048+512);
    if(d0==0){p0=__builtin_amdgcn_mfma_f32_32x32x16_bf16(b0,qr[0],negm,0,0,0);p1=__builtin_amdgcn_mfma_f32_32x32x16_bf16(b1,qr[0],negm,0,0,0);}
    else{p0=__builtin_amdgcn_mfma_f32_32x32x16_bf16(b0,qr[d0],p0,0,0,0);p1=__builtin_amdgcn_mfma_f32_32x32x16_bf16(b1,qr[d0],p1,0,0,0);}}
}
typedef __attribute__((address_space(3))) const char* lds_cptr;
typedef short v4i16_t __attribute__((ext_vector_type(4)));
__device__ __forceinline__ void kload8(bf16x8*kf,lds_cptr kp){
  kf[0]=*(const __attribute__((address_space(3))) bf16x8*)(kp);      kf[1]=*(const __attribute__((address_space(3))) bf16x8*)(kp+512);
  kf[2]=*(const __attribute__((address_space(3))) bf16x8*)(kp+2048); kf[3]=*(const __attribute__((address_space(3))) bf16x8*)(kp+2560);
  kf[4]=*(const __attribute__((address_space(3))) bf16x8*)(kp+4096); kf[5]=*(const __attribute__((address_space(3))) bf16x8*)(kp+4608);
  kf[6]=*(const __attribute__((address_space(3))) bf16x8*)(kp+6144); kf[7]=*(const __attribute__((address_space(3))) bf16x8*)(kp+6656);
}
__device__ __forceinline__ void kload2(bf16x8*kf,lds_cptr kp,int j){ kf[2*j]=*(const __attribute__((address_space(3))) bf16x8*)(kp+j*2048); kf[2*j+1]=*(const __attribute__((address_space(3))) bf16x8*)(kp+j*2048+512); }
__device__ __forceinline__ s16x4 vtr(lds_cptr p){ return __builtin_bit_cast(s16x4,__builtin_amdgcn_ds_read_tr16_b64_v4i16((__attribute__((address_space(3))) v4i16_t*)p)); }
__device__ __forceinline__ float rowmax(const f32x16&p0,const f32x16&p1){
  float a=max3f(p0[0],p0[1],p1[0]),b=max3f(p0[2],p0[3],p1[1]);a=max3f(a,p1[2],p1[3]);
  #pragma unroll
  for(int r=4;r<16;r+=4){a=max3f(a,p0[r],p0[r+1]);b=max3f(b,p0[r+2],p0[r+3]);a=max3f(a,p1[r],p1[r+1]);b=max3f(b,p1[r+2],p1[r+3]);}
  const float m=max2f(a,b);
  auto rr=__builtin_amdgcn_permlane32_swap(__float_as_uint(m),__float_as_uint(m),false,false);
  return max2f(__uint_as_float(rr[0]),__uint_as_float(rr[1]));
}
__device__ __forceinline__ void pv(f32x16*o,int vb,bf16x8 pa0,bf16x8 pa1,bf16x8 pa2,bf16x8 pa3){
  #pragma unroll
  for(int d0=0;d0<2;++d0){s16x4 lo[4],hi[4];
    #pragma unroll
    for(int ks=0;ks<4;++ks){
      asm volatile("ds_read_b64_tr_b16 %0,%1 offset:%c2":"=&v"(lo[ks]):"v"(vb),"i"(d0*4096+ks*1024):"memory");
      asm volatile("ds_read_b64_tr_b16 %0,%1 offset:%c2":"=&v"(hi[ks]):"v"(vb),"i"(d0*4096+ks*1024+512):"memory");}
    asm volatile("s_waitcnt lgkmcnt(0)":::"memory");SBAR();
    #define PK(k) (bf16x8){lo[k][0],lo[k][1],lo[k][2],lo[k][3],hi[k][0],hi[k][1],hi[k][2],hi[k][3]}
    o[d0]=__builtin_amdgcn_mfma_f32_32x32x16_bf16(pa0,PK(0),o[d0],0,0,0);
    o[d0]=__builtin_amdgcn_mfma_f32_32x32x16_bf16(pa1,PK(1),o[d0],0,0,0);
    o[d0]=__builtin_amdgcn_mfma_f32_32x32x16_bf16(pa2,PK(2),o[d0],0,0,0);
    o[d0]=__builtin_amdgcn_mfma_f32_32x32x16_bf16(pa3,PK(3),o[d0],0,0,0);
    #undef PK
  }
}

#ifndef ATTN_STORE16
#define ATTN_STORE16(p,v) (*(u32x4*)(p)=(v))
#endif
template<int THRL> __device__ __forceinline__ void attn_unit(int b,int h,int qb,const bf16*Q,const bf16* K,const bf16* V,const bf16* Gt,bf16*O,char*shm){
  int tid_=threadIdx.x; asm volatile("":"+v"(tid_)); const int tid=tid_,lane=tid&63,r32=lane&31,hi=lane>>5; const int wid=__builtin_amdgcn_readfirstlane(tid>>6);
  const long rowbase=(long)b*SEQ; const int q0=qb*QB;
  const bf16*Qw=Q+(rowbase+q0+wid*QBLK)*DM+h*D;
  const bf16*Kh=K+(long)(b*4+(h>>2))*64*4096,*Vh=V+(long)(b*4+(h>>2))*64*4096;
  const unsigned lds0=(unsigned)(uintptr_t)shm;
  float*wsf=(float*)(shm+LDS_WS)+wid*64;
  const bf16*ksrc=Kh+wid*512+lane*8;
  const bf16*vsrc=Vh+(wid>>2)*2048+(16*(wid&3)+(lane>>2))*32+(lane&3)*8;
  const unsigned kdst=lds0+LDS_K+wid*1024, vdst=lds0+LDS_V+wid*1024;
  #define DMA_K(t,slot) glds16(ksrc+(long)(t)*4096,(unsigned)__builtin_amdgcn_readfirstlane(kdst+(slot)))
  #define DMA_V(t,slot) glds16(vsrc+(long)(t)*4096,(unsigned)__builtin_amdgcn_readfirstlane(vdst+(slot)))
  const int vb0=(int)(lds0+LDS_V)+((lane>>4)&1)*32+(lane&3)*8+(4*hi+((lane&15)>>2))*64;
  const char*Kbase=shm+LDS_K; bf16x8 kf[8];
  const lds_cptr shm3=(lds_cptr)shm; const lds_cptr kp0=shm3+LDS_K+hi*1024+r32*16; const lds_cptr vp0=shm3+LDS_V+((lane>>4)&1)*32+(lane&3)*8+(4*hi+((lane&15)>>2))*64;
  const int NT=SEQ/KVBLK;
  DMA_K(0,0);DMA_V(0,0);DMA_K(1,SLOTB);
  bf16x8 qr[4];
  #pragma unroll
  for(int d0=0;d0<4;++d0)qr[d0]=*reinterpret_cast<const bf16x8*>(&Qw[(long)r32*DM+d0*16+hi*8]);
  float mhat=0.f,l_reg=0.f;f32x16 o[2];o[0]=f32x16{};o[1]=f32x16{};f32x16 negm=f32x16{};asm volatile("":"+v"(negm));
  const int qrel=wid*QBLK+r32;
  #define CMASK(P0,P1,t) do{}while(0)
  bool resc=false;
  #define START(P0,P1) do{ const float rm=rowmax(P0,P1); resc=false; \
    { const float dl=rm; mhat=fadd_s(mhat,dl); \
      _Pragma("unroll") for(int r=0;r<16;++r){P0[r]=fsub_s(P0[r],dl);P1[r]=fsub_s(P1[r],dl);} \
      _Pragma("unroll") for(int r=0;r<16;++r)negm[r]=-mhat; asm volatile("":"+v"(negm)); } \
    _Pragma("unroll") for(int r=0;r<16;++r)P0[r]=__builtin_amdgcn_exp2f(P0[r]); }while(0)
  #define RESC() do{ if(resc){ asm volatile("s_waitcnt lgkmcnt(0)":::"memory"); \
      _Pragma("unroll") for(int d_=0;d_<2;++d_) _Pragma("unroll") for(int r=0;r<16;++r)o[d_][r]*=wsf[crow(r,hi)]; } }while(0)
  f32x16 pA0,pA1,pB0,pB1;
  int sl_prev=0,sl_cur=0,sl_next=SLOTB;
  #define ROT() do{sl_prev=sl_cur;sl_cur=sl_next;sl_next=(sl_next==(NSLOT-1)*SLOTB)?0:sl_next+SLOTB;}while(0)
  DMA_K(2,2*SLOTB);
  WAIT_BAR(3);
  qkt(pA0,pA1,Kbase,qr,negm,r32,hi);asm volatile("s_nop 15\n\ts_nop 7":"+v"(pA0),"+v"(pA1));CMASK(pA0,pA1,0);
  START(pA0,pA1);
  _Pragma("unroll") for(int r=0;r<16;++r)pA1[r]=__builtin_amdgcn_exp2f(pA1[r]);
  WAIT_BAR(0);
  DMA_K(3,0);DMA_V(1,SLOTB);
  ROT();
  kload8(kf,kp0+sl_cur);
  WAIT_BAR(2);
  s16x4 vlo[8],vhi[8]; u32x4 pw0,pw1,pw2,pw3;
  #define PKW(P,B) cvtpk_s(P[B],P[B+1])
  #define PAF(k) __builtin_bit_cast(bf16x8,pw##k)
  #define VFR(i) (bf16x8){vlo[i][0],vlo[i][1],vlo[i][2],vlo[i][3],vhi[i][0],vhi[i][1],vhi[i][2],vhi[i][3]}
  #define PIN(x) asm volatile("":"+v"(x))
  #define MX3(a,b,c) __builtin_fmaxf(__builtin_fmaxf((a),(b)),(c))
  #define GAPA(MF,A0,A1,A2,A3,W0,W1,PW) do{ MF; sacc+=A0; sacc+=A1; sacc+=A2; sacc+=A3; PIN(sacc); W0; W1; PIN(PW); SBAR(); }while(0)
  #define EX(v) __builtin_amdgcn_exp2f(v)
  #define GAPB(MF,X,B) do{ MF; X[B]=EX(X[B]); X[B+1]=EX(X[B+1]); X[B+2]=EX(X[B+2]); X[B+3]=EX(X[B+3]); PIN(X); SBAR(); }while(0)
  #define VRD(i) do{ vlo[i]=vtr(vp_+(((i)>>2)*4096+((i)&3)*1024)); vhi[i]=vtr(vp_+(((i)>>2)*4096+((i)&3)*1024+512)); }while(0)
  #define KRD(G,j) do{ if(G){ kload2(kf,kp0+sl_next,j); SBAR(); } }while(0)
  #define STEP(C0,C1,P0,P1,t,GK,GV,GL) do{ SBAR(); \
    const lds_cptr vp_=vp0+sl_prev; \
    VRD(0); SBAR(); float sacc=(P0[0]+P0[1]); \
    GAPA(C0=__builtin_amdgcn_mfma_f32_32x32x16_bf16(kf[0],qr[0],negm,0,0,0), P0[2],P0[3],P0[4],P0[5],     pw0[0]=PKW(P0,0), pw0[1]=PKW(P0,2), pw0); \
    VRD(4); SBAR(); GAPA(C1=__builtin_amdgcn_mfma_f32_32x32x16_bf16(kf[1],qr[0],negm,0,0,0), P0[6],P0[7],P0[8],P0[9],     pw0[2]=PKW(P0,4), pw0[3]=PKW(P0,6), pw0); \
    VRD(1); SBAR(); GAPA(C0=__builtin_amdgcn_mfma_f32_32x32x16_bf16(kf[2],qr[1],C0,0,0,0),   P0[10],P0[11],P0[12],P0[13], pw1[0]=PKW(P0,8), pw1[1]=PKW(P0,10), pw1); \
    VRD(5); SBAR(); GAPA(C1=__builtin_amdgcn_mfma_f32_32x32x16_bf16(kf[3],qr[1],C1,0,0,0),   P0[14],P0[15],P1[0],P1[1],   pw1[2]=PKW(P0,12),pw1[3]=PKW(P0,14), pw1); \
    VRD(2); SBAR(); GAPA(C0=__builtin_amdgcn_mfma_f32_32x32x16_bf16(kf[4],qr[2],C0,0,0,0),   P1[2],P1[3],P1[4],P1[5],     pw2[0]=PKW(P1,0), pw2[1]=PKW(P1,2), pw2); \
    VRD(6); SBAR(); GAPA(C1=__builtin_amdgcn_mfma_f32_32x32x16_bf16(kf[5],qr[2],C1,0,0,0),   P1[6],P1[7],P1[8],P1[9],     pw2[2]=PKW(P1,4), pw2[3]=PKW(P1,6), pw2); \
    VRD(3); SBAR(); GAPA(C0=__builtin_amdgcn_mfma_f32_32x32x16_bf16(kf[6],qr[3],C0,0,0,0),   P1[10],P1[11],P1[12],P1[13], pw3[0]=PKW(P1,8), pw3[1]=PKW(P1,10), pw3); \
    VRD(7); SBAR(); GAPA(C1=__builtin_amdgcn_mfma_f32_32x32x16_bf16(kf[7],qr[3],C1,0,0,0),   P1[14],P1[15],0.f,0.f,       pw3[2]=PKW(P1,12),pw3[3]=PKW(P1,14), pw3); \
    l_reg+=sacc; \
    if(GK){DMA_K((t)+3,sl_cur);} if(GV){DMA_V((t)+1,sl_next);} \
    CMASK(C0,C1,t); \
    { float a=MX3(C0[0],C0[1],C1[0]),b=MX3(C0[2],C0[3],C1[1]); a=MX3(a,C1[2],C1[3]); \
      _Pragma("unroll") for(int r=4;r<16;r+=4){a=MX3(a,C0[r],C0[r+1]);b=MX3(b,C0[r+2],C0[r+3]);a=MX3(a,C1[r],C1[r+1]);b=MX3(b,C1[r+2],C1[r+3]);} \
      float rm=__builtin_fmaxf(a,b); { auto rr=__builtin_amdgcn_permlane32_swap(__float_as_uint(rm),__float_as_uint(rm),false,false); rm=__builtin_fmaxf(__uint_as_float(rr[0]),__uint_as_float(rr[1])); } \
      resc=false; \
      if(__builtin_expect(__any(rm>(float)THRL),0)){ const float dl=__builtin_fmaxf(rm,0.f); mhat+=dl; \
        _Pragma("unroll") for(int r=0;r<16;++r){C0[r]-=dl;C1[r]-=dl;} \
        _Pragma("unroll") for(int r=0;r<16;++r)negm[r]=-mhat; asm volatile("":"+v"(negm)); \
        const float f=__builtin_amdgcn_exp2f(-dl); l_reg*=f; if(hi==0)wsf[r32]=f; resc=true; } } \
    SBAR(); \
    GAPB(o[0]=__builtin_amdgcn_mfma_f32_32x32x16_bf16(PAF(0),VFR(0),o[0],0,0,0), C0,0); \
    GAPB(o[1]=__builtin_amdgcn_mfma_f32_32x32x16_bf16(PAF(0),VFR(4),o[1],0,0,0), C0,4); \
    KRD(GL,0); GAPB(o[0]=__builtin_amdgcn_mfma_f32_32x32x16_bf16(PAF(1),VFR(1),o[0],0,0,0), C0,8); \
    KRD(GL,1); GAPB(o[1]=__builtin_amdgcn_mfma_f32_32x32x16_bf16(PAF(1),VFR(5),o[1],0,0,0), C0,12); \
    KRD(GL,2); GAPB(o[0]=__builtin_amdgcn_mfma_f32_32x32x16_bf16(PAF(2),VFR(2),o[0],0,0,0), C1,0); \
    KRD(GL,3); GAPB(o[1]=__builtin_amdgcn_mfma_f32_32x32x16_bf16(PAF(2),VFR(6),o[1],0,0,0), C1,4); \
    GAPB(o[0]=__builtin_amdgcn_mfma_f32_32x32x16_bf16(PAF(3),VFR(3),o[0],0,0,0), C1,8); \
    GAPB(o[1]=__builtin_amdgcn_mfma_f32_32x32x16_bf16(PAF(3),VFR(7),o[1],0,0,0), C1,12); \
    }while(0)
  int t=1;
  #undef CMASK
  #define CMASK(P0,P1,t) do{}while(0)
  for(;t+5<NT;t+=2){
    STEP(pB0,pB1,pA0,pA1,t,true,true,true);     WAIT_BAR(2); RESC(); ROT();
    STEP(pA0,pA1,pB0,pB1,t+1,true,true,true);   WAIT_BAR(2); RESC(); ROT();
  }
  #undef CMASK
  #define CMASK(P0,P1,t) do{}while(0)
  #define ENDW(tt) do{ if((tt)+3<NT){WAIT_BAR(2);} else if((tt)+2<NT){WAIT_BAR(1);} else {WAIT_BAR(0);} }while(0)
  for(;t+1<NT;t+=2){
    STEP(pB0,pB1,pA0,pA1,t,(t+3<NT),(t+1<NT),(t+1<NT));       ENDW(t);   RESC(); ROT();
    STEP(pA0,pA1,pB0,pB1,t+1,(t+4<NT),(t+2<NT),(t+2<NT));     ENDW(t+1); RESC(); ROT();
  }
  const bf16*Gw=Gt+(rowbase+q0+wid*QBLK)*DM+h*D; u32x4 gpre[4];
  _Pragma("unroll") for(int i=0;i<4;++i) gpre[i]=*(const u32x4*)(Gw+(long)(i*8+(lane>>3))*DM+(lane&7)*8);
  STEP(pB0,pB1,pA0,pA1,NT-1,false,false,false); RESC();
  { float sacc=pB0[0]+pB0[1]; _Pragma("unroll") for(int r=2;r<16;++r)sacc+=pB0[r]; _Pragma("unroll") for(int r=0;r<16;++r)sacc+=pB1[r]; l_reg+=sacc;
    pw0=(u32x4){PKW(pB0,0),PKW(pB0,2),PKW(pB0,4),PKW(pB0,6)};pw1=(u32x4){PKW(pB0,8),PKW(pB0,10),PKW(pB0,12),PKW(pB0,14)};pw2=(u32x4){PKW(pB1,0),PKW(pB1,2),PKW(pB1,4),PKW(pB1,6)};pw3=(u32x4){PKW(pB1,8),PKW(pB1,10),PKW(pB1,12),PKW(pB1,14)};
    SBAR(); pv(o,vb0+sl_cur,PAF(0),PAF(1),PAF(2),PAF(3)); }
  #undef PKW
  #undef PAF
  #undef VFR
  #undef PIN
  #undef MX3
  #undef GAPA
  #undef GAPB
  #undef EX
  #undef VRD
  #undef KRD
  #undef STEP
  #undef ENDW
  {auto rr=__builtin_amdgcn_permlane32_swap(__float_as_uint(l_reg),__float_as_uint(l_reg),false,false);l_reg=__uint_as_float(rr[0])+__uint_as_float(rr[1]);}
  if(hi==0)wsf[32+r32]=l_reg;asm volatile("s_waitcnt lgkmcnt(0)":::"memory");
  float rli[16];
  #pragma unroll
  for(int r=0;r<16;++r)rli[r]=__builtin_amdgcn_rcpf(wsf[32+crow(r,hi)]);
  bf16*Ow=O+(rowbase+q0+wid*QBLK)*OPITCH+h*D;
  { bf16*stg=(bf16*)(shm+LDS_OST)+wid*2048;
    #pragma unroll
    for(int r=0;r<16;++r){const int orow=crow(r,hi);
      #pragma unroll
      for(int d0=0;d0<2;++d0)stg[orow*64+d0*32+r32]=__float2bfloat16(o[d0][r]*rli[r]);}
    asm volatile("s_waitcnt lgkmcnt(0)":::"memory");
    #pragma unroll
    for(int i=0;i<4;++i){const int row=i*8+(lane>>3),ch=lane&7; u32x4 v=*(const u32x4*)(stg+row*64+ch*8); const u32x4 gv=gpre[i]; v[0]=gate_mul2(v[0],gv[0]); v[1]=gate_mul2(v[1],gv[1]); v[2]=gate_mul2(v[2],gv[2]); v[3]=gate_mul2(v[3],gv[3]); ATTN_STORE16(Ow+(long)row*OPITCH+ch*8,v);} }
  asm volatile("s_waitcnt lgkmcnt(0)\n\ts_barrier":::"memory");
  #undef DMA_K
  #undef DMA_V
  #undef CMASK
  #undef START
  #undef RESC
  #undef ROT
}
constexpr int ATTN_LDS_BYTES=LDS_BYTES;
template<int THRL=8> __device__ __forceinline__ void attn_phase(char*lds,const bf16*P,const bf16*KT,const bf16*VTt,bf16*Pout,int vcu){
  const int grp=vcu>>3,s=vcu&7,b=grp>>2,kvh=grp&3;
  if(__builtin_amdgcn_readfirstlane(threadIdx.x>>6)<4) __builtin_amdgcn_s_setprio(2);
  for(int i=0;i<8;++i){ const int u=s*8+i; attn_unit<THRL>(b,kvh*4+(u>>4),u&15,P,KT,VTt,P+1536,Pout,lds); }
  __builtin_amdgcn_s_setprio(0);
}
#undef SBAR
#undef WAIT_BAR
}

namespace cg = cooperative_groups;
#define GAS __attribute__((address_space(1)))
#define LAS __attribute__((address_space(3)))
typedef unsigned short bf16;
typedef unsigned v4u __attribute__((ext_vector_type(4)));
typedef unsigned v2u __attribute__((ext_vector_type(2)));
typedef float f32x4 __attribute__((ext_vector_type(4)));
typedef float f32x16 __attribute__((ext_vector_type(16)));
typedef short bf16x8 __attribute__((ext_vector_type(8)));
typedef short s16x4 __attribute__((ext_vector_type(4)));
#define LDS_WAIT() asm volatile("s_waitcnt lgkmcnt(0)" ::: "memory")

#ifndef REP_NAT
#define REP_NAT 1
#endif
#ifndef REP_ATT
#define REP_ATT 1
#endif
#ifndef REP_P1
#define REP_P1 1
#endif
#ifndef REP_SYNC
#define REP_SYNC 1
#endif
#ifndef REP_PP
#define REP_PP 1
#endif
#ifndef REP_VT
#define REP_VT 1
#endif
#ifndef REP_NATC
#define REP_NATC 1
#endif
#ifndef REP_P3L0
#define REP_P3L0 1
#endif
#ifndef REP_P0
#define REP_P0 1
#endif
#ifndef MK_PER_PHASE
#define MK_PER_PHASE 0
#endif
constexpr int NWAVES = 8;
constexpr int BATCH = 8, SEQ = 4096, D = 1024, DEPTH = 4, PLE = 256, GW = 64;
constexpr int T = BATCH * SEQ;
constexpr int NA = 3072, NB = 2560;
constexpr float C2 = 0.125f * 1.4426950408889634f;
constexpr float LOG2E = 1.4426950408889634f;

constexpr size_t MiB = 1u << 20;
constexpr size_t WS_BAR = 0, BAR_ZERO_BYTES = 16384;
constexpr size_t WS_ROPE = 1 * MiB;
constexpr size_t WS_W = 2 * MiB;
constexpr size_t W_AQKG = 0, W_AV = 12 * MiB, W_B = 16 * MiB, W_AO = 26 * MiB, W_BO = 30 * MiB, W_G = 34 * MiB, W_P = 42 * MiB;
constexpr size_t WS_SS = 46 * MiB;
constexpr size_t SS_STAGE = (size_t)T * 16 * 4;
constexpr size_t WS_PB = 64 * MiB;
constexpr size_t WS_U = 128 * MiB, WS_V = 192 * MiB;
constexpr size_t WS_PROJ = 256 * MiB;
constexpr size_t WS_VT = 448 * MiB;
constexpr size_t WS_END = 512 * MiB;

constexpr int RING_BYTES = 131072, LDS_BYTES = 147456;
constexpr int MISC_OFF = LDS_BYTES - 64;

__device__ __forceinline__ unsigned f2bf(float f) { unsigned u = __builtin_bit_cast(unsigned, f); return (u + 0x7fffu + ((u >> 16) & 1u)) >> 16; }
__device__ __forceinline__ unsigned pk2(float lo, float hi) { return f2bf(lo) | (f2bf(hi) << 16); }
__device__ __forceinline__ float wave_sum(float v) {
#pragma unroll
    for (int o = 1; o < 64; o <<= 1) v += __shfl_xor(v, o);
    return v;
}

__device__ __forceinline__ void tr_item(const float* W, int ldw, int k0, int n0, bf16* WT, int K, int drow0, const float* gk, LAS float* scr, int lane, bool p32 = false) {
#pragma unroll 16
    for (int i = 0; i < 32; ++i) { const int kk = 2 * i + (lane >> 5); float w = W[(size_t)(k0 + kk) * ldw + n0 + (lane & 31)]; if (gk) w *= gk[k0 + kk]; scr[kk * 33 + (lane & 31)] = w; }
    LDS_WAIT(); asm volatile("" ::: "memory");
    const int c = lane & 7;
#pragma unroll
    for (int j = 0; j < 4; ++j) { const int n = (lane >> 3) + 8 * j; const LAS float* s = scr + (8 * c) * 33 + n;
        v4u o; o.x = pk2(s[0 * 33], s[1 * 33]); o.y = pk2(s[2 * 33], s[3 * 33]); o.z = pk2(s[4 * 33], s[5 * 33]); o.w = pk2(s[6 * 33], s[7 * 33]);
        const int nd = p32 ? 16 * ((n >> 2) & 1) + 4 * (n >> 3) + (n & 3) : n;
        __builtin_nontemporal_store(o, (GAS v4u*)(WT + (size_t)(drow0 + nd) * K + k0 + 8 * c)); }
    LDS_WAIT(); asm volatile("" ::: "memory");
}

struct Args { const float* in[14]; float* out; unsigned char* ws; int ph_lo, ph_hi; };

__device__ __forceinline__ void p0_prologue(const Args& a, LAS unsigned char* lds, int vcu, int G, int wave) {
    int tid_ = threadIdx.x; asm volatile("" : "+v"(tid_)); const int lane = tid_ & 63;
    unsigned char* ws = a.ws;
    LAS float* scr = (LAS float*)(lds + wave * 16384);
    const int gw = vcu * NWAVES + wave, NGW = G * NWAVES;
    bf16* wbase = (bf16*)(ws + WS_W);
    const float* norm_g = a.in[2];
    constexpr int I0 = 4096, I1 = 2560, I2 = 1024, I3 = 1024, I4 = 2048, I5 = 512, NITEMS = I0 + I1 + I2 + I3 + I4 + I5;
#pragma unroll 1
    for (int pass = 0; pass < 2; ++pass) {
    if (((wave & 1) == 0) == (pass == 0)) {
    for (int it = gw; it < NITEMS; it += NGW) {
        int r = it;
        if (r < I0) { const int j = r / 2048; r %= 2048; const int kb = r / 128, n0 = 32 * (r % 128), sec = n0 >> 10;
            bf16* WT = (sec == 2) ? (bf16*)((unsigned char*)wbase + W_AV) + (size_t)j * 1024 * 1024 : (bf16*)((unsigned char*)wbase + W_AQKG) + (size_t)j * 3072 * 1024;
            const int drow0 = (sec == 2) ? n0 - 2048 : (sec == 3 ? n0 - 1024 : n0);
            tr_item(a.in[3] + (size_t)j * 1024 * 4096, 4096, 64 * kb, n0, WT, 1024, drow0, norm_g + (2 * j) * 1024, scr, lane); continue; }
        r -= I0;
        if (r < I1) { const int j = r / 1280; r %= 1280; const int kb = r / 80, n0 = 32 * (r % 80);
            const bool vg = n0 >= 1280;
            const int drow0 = vg ? n0 : (n0 & ~255) + 128 * ((n0 >> 5) & 1) + 32 * ((n0 >> 6) & 3);
            tr_item(a.in[6] + (size_t)j * 1024 * 2560, 2560, 64 * kb, n0, (bf16*)((unsigned char*)wbase + W_B) + (size_t)j * 2560 * 1024, 1024, drow0, norm_g + (2 * j + 1) * 1024, scr, lane, vg); continue; }
        r -= I1;
        if (r < I2) { const int j = r / 512; r %= 512; const int kb = r / 32, n0 = 32 * (r % 32);
            tr_item(a.in[5] + (size_t)j * 1024 * 1024, 1024, 64 * kb, n0, (bf16*)((unsigned char*)wbase + W_AO) + (size_t)j * 1024 * 1024, 1024, n0, nullptr, scr, lane); continue; }
        r -= I2;
        if (r < I3) { const int j = r / 512; r %= 512; const int kb = r / 32, n0 = 32 * (r % 32);
            tr_item(a.in[9] + (size_t)j * 1024 * 1024, 1024, 64 * kb, n0, (bf16*)((unsigned char*)wbase + W_BO) + (size_t)j * 1024 * 1024, 1024, n0, nullptr, scr, lane); continue; }
        r -= I3;
        if (r < I4) { const int i = r / 512; r %= 512; const int kb = r / 32, n0 = 32 * (r % 32);
            tr_item(a.in[11] + (size_t)i * 1024 * 1024, 1024, 64 * kb, n0, (bf16*)((unsigned char*)wbase + W_G) + (size_t)i * 1024 * 1024, 1024, n0, a.in[10] + i * 1024, scr, lane); continue; }
        r -= I4;
        { const int i = r / 128; r %= 128; const int kb = r / 32, n0 = 32 * (r % 32);
            tr_item(a.in[12] + (size_t)i * 256 * 1024, 1024, 64 * kb, n0, (bf16*)((unsigned char*)wbase + W_P) + (size_t)i * 1024 * 256, 256, n0, nullptr, scr, lane); }
    }
    } else {
    { const f32x4* src = (const f32x4*)a.in[1]; v4u* dst = (v4u*)(ws + WS_PB); const size_t n8 = (size_t)DEPTH * T * PLE / 8;
#pragma unroll 4
      for (size_t i = (size_t)gw * 64 + lane; i < n8; i += (size_t)NGW * 64) { const f32x4 v0 = __builtin_nontemporal_load(src + 2 * i), v1 = __builtin_nontemporal_load(src + 2 * i + 1);
          v4u o; o.x = pk2(v0[0], v0[1]); o.y = pk2(v0[2], v0[3]); o.z = pk2(v1[0], v1[1]); o.w = pk2(v1[2], v1[3]); __builtin_nontemporal_store(o, dst + i); } }
    { const float* x = a.in[0]; bf16* xb = (bf16*)(ws + WS_U); float* ss0 = (float*)(ws + WS_SS);
#pragma unroll 2
      for (int m = gw; m < T; m += NGW) { const f32x4* xr = (const f32x4*)(x + (size_t)m * D) + lane; f32x4 v[4]; float s = 0.f;
#pragma unroll
          for (int j = 0; j < 4; ++j) { v[j] = xr[64 * j]; s += (v[j][0] * v[j][0] + v[j][1] * v[j][1]) + (v[j][2] * v[j][2] + v[j][3] * v[j][3]); }
          s = wave_sum(s);
          v2u* o8 = (v2u*)(xb + (size_t)m * D) + lane;
#pragma unroll
          for (int j = 0; j < 4; ++j) { v2u o; o.x = pk2(v[j][0], v[j][1]); o.y = pk2(v[j][2], v[j][3]); __builtin_nontemporal_store(o, o8 + 64 * j); }
          if (lane < 16) ss0[(size_t)m * 16 + lane] = (lane == 0) ? s : 0.f; } }
    } }
    { const int gid = gw * 64 + lane;
      if (gid < 1024) { const int pos = gid >> 4, j = gid & 15; double th = 1.0; for (int q = 0; q < j; ++q) th *= 0.56234132519034908;
          const double t2 = th * th; double sn = 0.0, cn = 0.0, ts = th, tc = 1.0;
          for (int q = 0; q < 12; ++q) { cn += tc; sn += ts; tc *= -t2 / ((2 * q + 1) * (2 * q + 2)); ts *= -t2 / ((2 * q + 2) * (2 * q + 3)); }
          double cr = 1.0, sr = 0.0; for (int q = 0; q < pos; ++q) { const double c1 = cr * cn - sr * sn, s1 = sr * cn + cr * sn; cr = c1; sr = s1; }
          float* rc = (float*)(ws + WS_ROPE); rc[gid] = (float)cr; rc[1024 + gid] = (float)sr; } }
}

constexpr int NAT_K = 0, NAT_KSLOT = 6144, NAT_V = 67584, NAT_VD = 1072, NAT_TAB = 136192;
__device__ __forceinline__ void natten_phase(LAS unsigned char* lds, const bf16* P, const bf16* VT, bf16* O, const float* rpb, int vcu, int G, int wave) {
    int tid_ = threadIdx.x; asm volatile("" : "+v"(tid_)); const int tid = tid_, lane = tid_ & 63;
    const int q = lane & 15, g = lane >> 4;
    if (wave < 4) __builtin_amdgcn_s_setprio(2);
    for (int wu = vcu; wu < 256; wu += G) {
        const int b = wu >> 5, h = (wu >> 1) & 15, half = wu & 1, kc0 = 16 * half;
        __syncthreads();
        { LAS float* tab = (LAS float*)(lds + NAT_TAB); if (tid < 465) tab[tid] = rpb[h * 465 + tid] * LOG2E; if (tid < 256) tab[512 + tid] = -INFINITY; }
        const unsigned char* kbase = (const unsigned char*)(P + ((size_t)T * 1024) + ((size_t)(b * 16 + h) * SEQ) * 64);
        const unsigned char* vbase = (const unsigned char*)(VT + ((size_t)(b * 16 + h) * 64) * 64 * 64);
        unsigned kg_[3], vg_[3], kl_[3], vl_[3]; int kri[3], vri[3];
#pragma unroll
        for (int k = 0; k < 3; ++k) { const int id = tid + 512 * k, ri = id / 384, rem = id - ri * 384;
            { const int col = rem >> 3, c = rem & 7; kri[k] = ri;
              kg_[k] = (unsigned)(((ri * 64 + kc0 + col) * 64 + 8 * c) * 2);
              kl_[k] = (unsigned)(NAT_K + col * 128 + ((c ^ ((col >> 1) & 7)) << 4)); }
            { const int d = rem / 6, ch = rem - 6 * d; vri[k] = ri;
              vg_[k] = (unsigned)((((ri * 64) + d) * 64 + kc0 + 8 * ch) * 2);
              vl_[k] = (unsigned)(NAT_V + d * NAT_VD + ch * 16); } }
        v4u kreg[3], vreg[3];
#define NAT_ISSUE(first, n) do { const unsigned char* kb_ = kbase + (size_t)(first) * 8192; const unsigned char* vb_ = vbase + (size_t)(first) * 8192; \
        _Pragma("unroll") for (int k = 0; k < 3; ++k) { if (kri[k] < (n)) kreg[k] = *(const v4u*)(kb_ + kg_[k]); if (vri[k] < (n)) vreg[k] = *(const v4u*)(vb_ + vg_[k]); } } while (0)
#define NAT_COMMIT(first, n) do { _Pragma("unroll") for (int k = 0; k < 3; ++k) { \
            if (kri[k] < (n)) { const int sl = ((first) + kri[k]) % 11; *(LAS v4u*)(lds + kl_[k] + sl * NAT_KSLOT) = kreg[k]; } \
            if (vri[k] < (n)) { const int sl = ((first) + vri[k]) % 11; *(LAS v4u*)(lds + vl_[k] + sl * 96) = vreg[k]; } } } while (0)
        NAT_ISSUE(0, 4); NAT_COMMIT(0, 4); NAT_ISSUE(4, 4); NAT_COMMIT(4, 4);
        __syncthreads();
        const int cg2 = wave & 1, c0 = 32 * half + 16 * cg2, wsx = (half ? 8 : 0) + 8 * cg2;
        const int cs = min(max(c0 + q - 8, 0), 48);
        const int vl0 = wsx + 4 * g + kc0 - cs;
        const int swz = ((wsx >> 1) + (q >> 1)) & 7;
        const unsigned kb0 = (unsigned)(NAT_K + (wsx + q) * 128), kb1 = kb0 + 2048u;
        const unsigned ko00 = (unsigned)(((0 + g) ^ swz) << 4), ko01 = (unsigned)(((4 + g) ^ swz) << 4);
        const unsigned vb = (unsigned)(NAT_V + q * NAT_VD + (wsx + 4 * g) * 2); unsigned vb2 = vb + 32u; asm volatile("" : "+v"(vb2));
        const size_t tokh0 = (size_t)(b * 16 + h) * SEQ + (wave >> 1) * 64 + c0 + q;
        const bf16* qptr = P + tokh0 * 64 + 8 * g; const bf16* gptr = P + ((size_t)T * 2048) + tokh0 * 64 + 4 * g;
        bf16x8 qn0 = __builtin_nontemporal_load((const bf16x8*)(qptr)), qn1 = __builtin_nontemporal_load((const bf16x8*)(qptr + 32));
#pragma unroll 1
        for (int tt = 0; tt < 16 * REP_NATC; ++tt) {
            const int t = tt / REP_NATC; const bool lastrep = (tt % REP_NATC) == REP_NATC - 1;
            const int hi_t = min(max(4 * t + 6, 7), 63), hi_n = (t < 15) ? min(max(4 * t + 10, 7), 63) : hi_t, first = hi_t + 1, nn = lastrep ? hi_n - hi_t : 0;
            if (nn > 0) NAT_ISSUE(first, nn);
            const bf16x8 qf0 = qn0, qf1 = qn1;
            if (t < 15 && lastrep) { const size_t adv = (size_t)(t + 1) * 4 * 64 * 64; qn0 = __builtin_nontemporal_load((const bf16x8*)(qptr + adv)); qn1 = __builtin_nontemporal_load((const bf16x8*)(qptr + adv + 32)); }
            {
                const int r = 4 * t + (wave >> 1), rs = min(max(r - 4, 0), 56);
                const size_t tokq = (size_t)b * SEQ + r * 64 + c0 + q;
                const int s0 = rs % 11;
                const unsigned tb = (unsigned)(NAT_TAB + 4 * ((rs - r + 7) * 31 + kc0 + wsx + 4 * g - c0 - q + 15));
                unsigned a8[8];
#pragma unroll
                for (int j = 0; j < 8; ++j) { const int cb = j >> 2, i = j & 3; a8[j] = ((unsigned)(16 * cb + i + vl0) < 16u) ? tb + 4u * (unsigned)(16 * cb + i) : (unsigned)(NAT_TAB + 2048); }
                f32x4 p[16];
                bf16x8 kc[4], kn[4]; float mx = -1e30f;
#define NAT_LDK(dst, kr_) do { const int sl_ = (s0 + (kr_) >= 11) ? s0 + (kr_) - 11 : s0 + (kr_); const unsigned so_ = (unsigned)sl_ * NAT_KSLOT; \
                    dst[0] = *(const LAS bf16x8*)(lds + kb0 + so_ + ko00); dst[1] = *(const LAS bf16x8*)(lds + kb0 + so_ + ko01); \
                    dst[2] = *(const LAS bf16x8*)(lds + kb1 + so_ + ko00); dst[3] = *(const LAS bf16x8*)(lds + kb1 + so_ + ko01); } while (0)
#define NAT_LDB(kr_) do { _Pragma("unroll") for (int i = 0; i < 4; ++i) { p[2 * (kr_)][i] = *((const LAS float*)(lds + a8[i]) + (kr_) * 31); p[2 * (kr_) + 1][i] = *((const LAS float*)(lds + a8[4 + i]) + (kr_) * 31); } } while (0)
                NAT_LDK(kc, 0); NAT_LDB(0);
#pragma unroll
                for (int kr = 0; kr < 8; ++kr) {
                    if (kr < 7) { NAT_LDK(kn, kr + 1); NAT_LDB(kr + 1); }
                    __builtin_amdgcn_sched_barrier(0);
                    f32x4 a0 = p[2 * kr], a1 = p[2 * kr + 1];
                    a0 = __builtin_amdgcn_mfma_f32_16x16x32_bf16(kc[0], qf0, a0, 0, 0, 0); a1 = __builtin_amdgcn_mfma_f32_16x16x32_bf16(kc[2], qf0, a1, 0, 0, 0);
                    a0 = __builtin_amdgcn_mfma_f32_16x16x32_bf16(kc[1], qf1, a0, 0, 0, 0); a1 = __builtin_amdgcn_mfma_f32_16x16x32_bf16(kc[3], qf1, a1, 0, 0, 0);
                    if (kr > 0) {
                        mx = fmaxf(fmaxf(mx, fmaxf(p[2 * kr - 2][0], p[2 * kr - 2][1])), fmaxf(p[2 * kr - 2][2], p[2 * kr - 2][3]));
                        mx = fmaxf(fmaxf(mx, fmaxf(p[2 * kr - 1][0], p[2 * kr - 1][1])), fmaxf(p[2 * kr - 1][2], p[2 * kr - 1][3])); }
                    p[2 * kr] = a0; p[2 * kr + 1] = a1;
                    __builtin_amdgcn_sched_barrier(0);
#pragma unroll
                    for (int j = 0; j < 4; ++j) kc[j] = kn[j]; }
#undef NAT_LDK
#undef NAT_LDB
                mx = fmaxf(fmaxf(mx, fmaxf(p[14][0], p[14][1])), fmaxf(p[14][2], p[14][3]));
                mx = fmaxf(fmaxf(mx, fmaxf(p[15][0], p[15][1])), fmaxf(p[15][2], p[15][3]));
                mx = fmaxf(mx, __shfl_xor(mx, 16)); mx = fmaxf(mx, __shfl_xor(mx, 32));
                if (__builtin_expect(__any(fabsf(mx) > 64.f), 0)) {
#pragma unroll
                    for (int bk = 0; bk < 16; ++bk)
#pragma unroll
                        for (int i = 0; i < 4; ++i) p[bk][i] -= mx; }
                f32x4 o[4], osum = {0.f, 0.f, 0.f, 0.f};
                const bf16x8 ones = {(short)0x3F80, (short)0x3F80, (short)0x3F80, (short)0x3F80, (short)0x3F80, (short)0x3F80, (short)0x3F80, (short)0x3F80};
#pragma unroll
                for (int db = 0; db < 4; ++db) o[db] = (f32x4){0.f, 0.f, 0.f, 0.f};
                v2u gc[4];
#pragma unroll
                for (int db = 0; db < 4; ++db) gc[db] = __builtin_nontemporal_load((const v2u*)(gptr + (size_t)t * 4 * 64 * 64 + 16 * db));
                s16x4 vc[8], vn[8];
#define NAT_LDV(dst, kr_) do { const int sl_ = (s0 + (kr_) >= 11) ? s0 + (kr_) - 11 : s0 + (kr_); const unsigned so_ = (unsigned)sl_ * 96u; \
                    _Pragma("unroll") for (int db = 0; db < 4; ++db) { dst[2 * db] = *(const LAS s16x4*)(lds + vb + so_ + db * (16 * NAT_VD)); dst[2 * db + 1] = *(const LAS s16x4*)(lds + vb2 + so_ + db * (16 * NAT_VD)); } } while (0)
                NAT_LDV(vc, 0);
#pragma unroll
                for (int kr = 0; kr < 8; ++kr) {
                    if (kr < 7) NAT_LDV(vn, kr + 1);
#pragma unroll
                    for (int i = 0; i < 4; ++i) { p[2 * kr][i] = __builtin_amdgcn_exp2f(p[2 * kr][i]); p[2 * kr + 1][i] = __builtin_amdgcn_exp2f(p[2 * kr + 1][i]); }
                    v4u pw; pw.x = attn_body::cvtpk_s(p[2 * kr][0], p[2 * kr][1]); pw.y = attn_body::cvtpk_s(p[2 * kr][2], p[2 * kr][3]);
                    pw.z = attn_body::cvtpk_s(p[2 * kr + 1][0], p[2 * kr + 1][1]); pw.w = attn_body::cvtpk_s(p[2 * kr + 1][2], p[2 * kr + 1][3]);
                    const bf16x8 pf = __builtin_bit_cast(bf16x8, pw);
                    __builtin_amdgcn_sched_barrier(0);
                    osum = __builtin_amdgcn_mfma_f32_16x16x32_bf16(ones, pf, osum, 0, 0, 0);
#pragma unroll
                    for (int db = 0; db < 4; ++db) { const bf16x8 va = __builtin_shufflevector(vc[2 * db], vc[2 * db + 1], 0, 1, 2, 3, 4, 5, 6, 7);
                        o[db] = __builtin_amdgcn_mfma_f32_16x16x32_bf16(va, pf, o[db], 0, 0, 0); }
                    __builtin_amdgcn_sched_barrier(0);
#pragma unroll
                    for (int j = 0; j < 8; ++j) vc[j] = vn[j]; }
#undef NAT_LDV
                const float inv = __builtin_amdgcn_rcpf(osum[0]);
                bf16* orow = O + tokq * D + h * 64;
                v2u wq[4];
#pragma unroll
                for (int db = 0; db < 4; ++db) { const v2u gv = gc[db];
                    const float g0 = __uint_as_float(gv.x << 16), g1 = __uint_as_float(gv.x & 0xffff0000u), g2 = __uint_as_float(gv.y << 16), g3 = __uint_as_float(gv.y & 0xffff0000u);
                    wq[db].x = attn_body::cvtpk_s(o[db][0] * inv * attn_body::silu_f(g0), o[db][1] * inv * attn_body::silu_f(g1));
                    wq[db].y = attn_body::cvtpk_s(o[db][2] * inv * attn_body::silu_f(g2), o[db][3] * inv * attn_body::silu_f(g3)); }
#pragma unroll
                for (int pr = 0; pr < 2; ++pr) { v2u wa = wq[2 * pr], wb = wq[2 * pr + 1];
                    { auto r0 = __builtin_amdgcn_permlane16_swap(wa.x, wb.x, false, false); wa.x = r0[0]; wb.x = r0[1];
                      auto r1 = __builtin_amdgcn_permlane16_swap(wa.y, wb.y, false, false); wa.y = r1[0]; wb.y = r1[1]; }
                    v4u ww; ww.x = wa.x; ww.y = wa.y; ww.z = wb.x; ww.w = wb.y;
                    const int d0 = (g & 1) ? 16 * (2 * pr + 1) + 4 * (g - 1) : 16 * (2 * pr) + 4 * g;
                    *(v4u*)(orow + d0) = ww; }
            }
            asm volatile("s_waitcnt lgkmcnt(0)\n\ts_barrier" ::: "memory");
            if (nn > 0) NAT_COMMIT(first, nn);
            asm volatile("s_waitcnt lgkmcnt(0)\n\ts_barrier" ::: "memory");
        }
#undef NAT_ISSUE
#undef NAT_COMMIT
    }
    __builtin_amdgcn_s_setprio(0);
}

__device__ __forceinline__ void final_norm(const bf16* r, float* out, const float* ssp, const float* g, int vcu, int G, int wave) {
    int tid_ = threadIdx.x; asm volatile("" : "+v"(tid_)); const int lane = tid_ & 63;
    const int gw = vcu * NWAVES + wave, NGW = G * NWAVES;
    f32x4 gv[4];
#pragma unroll
    for (int j = 0; j < 4; ++j) gv[j] = *((const f32x4*)g + 2 * lane + (j & 1) + 128 * (j >> 1));
    for (int m = gw; m < T; m += NGW) {
        float s = (lane < 16) ? ssp[(size_t)m * 16 + lane] : 0.f; s = wave_sum(s);
        const float rs = rsqrtf(s * (1.0f / D) + 1e-6f);
        const v4u* rr = (const v4u*)(r + (size_t)m * D) + lane; f32x4* xo = (f32x4*)(out + (size_t)m * D) + 2 * lane;
#pragma unroll
        for (int j2 = 0; j2 < 2; ++j2) { const v4u w = rr[64 * j2];
            f32x4 v0, v1; v0[0] = __uint_as_float(w.x << 16); v0[1] = __uint_as_float(w.x & 0xffff0000u); v0[2] = __uint_as_float(w.y << 16); v0[3] = __uint_as_float(w.y & 0xffff0000u);
            v1[0] = __uint_as_float(w.z << 16); v1[1] = __uint_as_float(w.z & 0xffff0000u); v1[2] = __uint_as_float(w.w << 16); v1[3] = __uint_as_float(w.w & 0xffff0000u);
            xo[128 * j2] = v0 * rs * gv[2 * j2]; xo[128 * j2 + 1] = v1 * rs * gv[2 * j2 + 1]; }
    }
}

typedef GAS unsigned gu32;
#define XB_TMO      128
#define XB_XCNT(j)  (256  + 64 * (j))
#define XB_XSUB(j)  (1280 + 64 * (j))
#define XB_XGEN(j)  (2304 + 64 * (j))
#define XB_TOP      3328
#define XB_TOPGEN   3392
#define XCD_BAR_WORDS 3456
#define XB_SPIN_CAP (1u << 18)

__device__ __forceinline__ unsigned xb_ld(unsigned* p)              { return __hip_atomic_load(p, __ATOMIC_RELAXED, __HIP_MEMORY_SCOPE_AGENT); }
__device__ __forceinline__ unsigned xb_add(unsigned* p, unsigned v) { return __hip_atomic_fetch_add(p, v, __ATOMIC_RELAXED, __HIP_MEMORY_SCOPE_AGENT); }
__device__ __forceinline__ unsigned xb_xcc_id() { return (unsigned)__builtin_amdgcn_s_getreg((3 << 11) | 20) & 0xFu; }
#define XB_SPIN(cond, bar) do { unsigned _sp = 0; while (cond) { __builtin_amdgcn_s_sleep(1); \
    if ((++_sp & 255u) == 0u) { if (xb_ld(&(bar)[XB_TMO])) break; if (_sp > XB_SPIN_CAP) { atomicAdd(&(bar)[XB_TMO], 1u); break; } } } } while (0)

struct XcdBarrier {
    unsigned* bar; unsigned x;
    volatile LAS unsigned* st;
};

__device__ __forceinline__ XcdBarrier xcd_barrier_post(unsigned* bar, volatile LAS unsigned* st) {
    XcdBarrier b; b.bar = bar; b.x = xb_xcc_id(); b.st = st;
    if (threadIdx.x == 0) (void)xb_add(&bar[XB_XCNT(b.x)], 1u);
    return b;
}
__device__ __forceinline__ void xcd_barrier_complete(unsigned* bar, unsigned x, unsigned& nloc, unsigned& nx) {
    const unsigned G = gridDim.x * gridDim.y * gridDim.z;
    unsigned sum, cnt, mine, sp = 0u;
    for (;;) {
        sum = 0u; cnt = 0u; mine = 0u;
#pragma unroll
        for (unsigned j = 0; j < 16; ++j) { const unsigned c = xb_ld(&bar[XB_XCNT(j)]); sum += c; cnt += (c > 0u) ? 1u : 0u; mine = (j == x) ? c : mine; }
        if (sum == G) break;
        __builtin_amdgcn_s_sleep(1);
        if ((++sp & 255u) == 0u) { if (xb_ld(&bar[XB_TMO])) break; if (sp > XB_SPIN_CAP) { atomicAdd(&bar[XB_TMO], 1u); break; } }
    }
    nloc = mine > 0u ? mine : 1u; nx = cnt > 0u ? cnt : 1u;
}

__device__ __forceinline__ void xcd_barrier(const XcdBarrier& b) {
    asm volatile("s_waitcnt vmcnt(0)" ::: "memory");
    __syncthreads();
    if (threadIdx.x == 0) {
        unsigned* bar = b.bar;
        __builtin_amdgcn_s_waitcnt(0);
        unsigned nloc = b.st[0], nx = b.st[1];
        if (nloc == 0u) { xcd_barrier_complete(bar, b.x, nloc, nx); b.st[0] = nloc; b.st[1] = nx; }
        const unsigned old = xb_add(&bar[XB_XSUB(b.x)], 1u);
        const unsigned gen = old / nloc;
        if (old + 1u == (gen + 1u) * nloc) {
            __builtin_amdgcn_fence(__ATOMIC_RELEASE, "agent");
            asm volatile("s_waitcnt vmcnt(0)" ::: "memory");
            const unsigned og = xb_add(&bar[XB_TOP], 1u);
            const unsigned tg = og / nx;
            if (og + 1u == (tg + 1u) * nx) xb_add(&bar[XB_TOPGEN], 1u);
            else XB_SPIN(xb_ld(&bar[XB_TOPGEN]) == tg, bar);
            __builtin_amdgcn_fence(__ATOMIC_ACQUIRE, "agent");
            xb_add(&bar[XB_XGEN(b.x)], 1u);
            asm volatile("s_waitcnt vmcnt(0)" ::: "memory");
        } else {
            XB_SPIN(xb_ld(&bar[XB_XGEN(b.x)]) == gen, bar);
            __builtin_amdgcn_fence(__ATOMIC_ACQUIRE, "agent");
            asm volatile("s_waitcnt vmcnt(0)" ::: "memory");
        }
    }
    __syncthreads();
}
constexpr int N_PHASES = 2 + 4 * DEPTH;
__global__ void __launch_bounds__(NWAVES * 64, 2) mk_fwd(Args args) {
    extern __shared__ __attribute__((aligned(16))) unsigned char lds[];
    LAS unsigned char* L = (LAS unsigned char*)lds;
    const int tid = threadIdx.x, lane = tid & 63, wave = __builtin_amdgcn_readfirstlane(tid >> 6);
    const int G = gridDim.x, bx = blockIdx.x, vcu = (G % 8 == 0) ? (bx % 8) * (G / 8) + bx / 8 : bx;
    unsigned char* ws = args.ws;
    const int lo = args.ph_lo, hi = args.ph_hi;
#define IN(k) (lo <= (k) && (k) < hi)
    if (tid < 2) ((volatile LAS unsigned*)(L + MISC_OFF))[tid] = 0u;
    __syncthreads();
    XcdBarrier xbar; xbar.bar = (unsigned*)(ws + WS_BAR); xbar.x = 0; xbar.st = (volatile LAS unsigned*)(L + MISC_OFF);
#if MK_PER_PHASE
    if (hi - lo > 1) xbar = xcd_barrier_post((unsigned*)(ws + WS_BAR), (volatile LAS unsigned*)(L + MISC_OFF));
#else
    if (IN(0) && bx == 0) for (int i = tid; i < (int)(BAR_ZERO_BYTES / 4); i += NWAVES * 64) ((unsigned*)(ws + WS_BAR))[i] = 0u;
#endif
#define SEAM(k) do { if (IN(k) && IN((k) + 1)) for (int rep_ = 0; rep_ < REP_SYNC; ++rep_) { if ((k) == 0) cg::this_grid().sync(); else xcd_barrier(xbar); } } while (0)
#ifndef SKIP_P0
    for (int rep = 0; rep < REP_P0; ++rep)
    if (IN(0)) p0_prologue(args, L, vcu, G, wave);
#endif
    SEAM(0);
#if !MK_PER_PHASE
    xbar = xcd_barrier_post((unsigned*)(ws + WS_BAR), (volatile LAS unsigned*)(L + MISC_OFF));
#endif
    bf16* OB = (bf16*)args.out;
    bf16* PROJ = (bf16*)(ws + WS_PROJ); bf16* VT = (bf16*)(ws + WS_VT);
    const float* ropec = (const float*)(ws + WS_ROPE); const float* ropes = ropec + 1024;
#pragma unroll 1
    for (int i = 0; i < DEPTH; ++i) {
        const int j = i >> 1; const bool isA = (i & 1) == 0; const int pb0 = 1 + 4 * i;
        bf16* XB = (bf16*)(ws + ((i & 1) ? WS_V : WS_U));
        bf16* PP = (bf16*)(ws + ((i & 1) ? WS_U : WS_V));
        const float* ss_in = (const float*)(ws + WS_SS + (size_t)(2 * i) * SS_STAGE);
        float* ss_mid = (float*)(ws + WS_SS + (size_t)(2 * i + 1) * SS_STAGE);
        float* ss_out = (float*)(ws + WS_SS + (size_t)(2 * i + 2) * SS_STAGE);
        const bf16* wb = (const bf16*)(ws + WS_W);
        for (int rep = 0; rep < REP_P1; ++rep)
        if (IN(pb0)) {
            const bool ppfirst = (bx & 1) != 0;
#pragma unroll 1
            for (int pass = 0; pass < 2; ++pass) {
            if ((pass == 0) != ppfirst) {
#ifndef SKIP_G1A
            if (isA) {
                { pg8::Gemm g{XB, (const bf16*)((const unsigned char*)wb + W_AQKG) + (size_t)j * 3072 * 1024, T, NA, D, D, D}; pg8::StaticOrder S; S.init(T, NA, G, bx);
                  pg8::EpiBf16S<1, true> E{PROJ, NA, ss_in, 1024, C2};
                  pg8::gemm_phase<pg8::EpiBf16S<1, true>, pg8::StaticOrder, true, true>(L, g, S, E); }
                for (int rvt = 0; rvt < REP_VT; ++rvt)
                { pg8::Gemm g{(const bf16*)((const unsigned char*)wb + W_AV) + (size_t)j * 1024 * 1024, XB, D, T, D, D, D}; pg8::StaticOrder S; S.init(D, T, G, bx);
                  pg8::EpiBf16S<2, true> E{VT, T, ss_in, 0, 1.f};
                  pg8::gemm_phase<pg8::EpiBf16S<2, true>, pg8::StaticOrder, true, true>(L, g, S, E); }
            }
#endif
#ifndef SKIP_G1B
            if (!isA) {
                pg8::Gemm g{XB, (const bf16*)((const unsigned char*)wb + W_B) + (size_t)j * 2560 * 1024, T, NB, D, D, D}; pg8::StaticOrder S; S.init(T, NB, G, bx);
                pg8::EpiQKRope E{PROJ, NB, ss_in, args.in[7] + j * 64, args.in[8] + j * 64, ropec, ropes, C2, VT, VT + (size_t)8 * 1024 * 1024};
                pg8::gemm_phase<pg8::EpiQKRope, pg8::StaticOrder, true, true>(L, g, S, E);
            }
#endif
            } else {
#ifndef SKIP_GPP
            for (int rpp = 0; rpp < REP_PP; ++rpp)
            { pg8::Gemm g{(const bf16*)(ws + WS_PB) + (size_t)i * T * PLE, (const bf16*)((const unsigned char*)wb + W_P) + (size_t)i * 1024 * 256, T, D, PLE, PLE, PLE}; pg8::StaticOrder S; S.init(T, D, G, bx);
              pg8::EpiBf16S<0> E{PP, D, nullptr, 0, 1.f};
              pg8::gemm_phase<pg8::EpiBf16S<0>, pg8::StaticOrder, true, true>(L, g, S, E); }
#endif
            } }
        }
        SEAM(pb0);
        if (IN(pb0 + 1)) {
#ifndef SKIP_NAT
            for (int rep = 0; rep < REP_NAT; ++rep)
            if (isA) natten_phase(L, PROJ, VT, OB, args.in[4] + (size_t)j * 16 * 465, vcu, G, wave);
#endif
#ifndef SKIP_ATT
            for (int rep = 0; rep < REP_ATT; ++rep)
            if (!isA) attn_body::attn_phase<8>((char*)lds, (const attn_body::bf16*)PROJ, (const attn_body::bf16*)VT, (const attn_body::bf16*)(VT + (size_t)8 * 1024 * 1024), (attn_body::bf16*)OB, vcu);
#endif
        }
        SEAM(pb0 + 1);
#ifndef SKIP_G3
        for (int rep = 0; rep < ((i == 0) ? REP_P3L0 : 1); ++rep)
        if (IN(pb0 + 2)) {
            const bf16* wo = (const bf16*)((const unsigned char*)wb + (isA ? W_AO : W_BO)) + (size_t)j * 1024 * 1024;
            pg8::Gemm g{OB, wo, T, D, D, D, D}; pg8::StaticOrder S; S.init(T, D, G, bx);
            pg8::EpiResid<false> E{i == 0 ? args.in[0] : nullptr, XB, XB, nullptr, nullptr, ss_mid};
            pg8::gemm_phase<pg8::EpiResid<false>, pg8::StaticOrder, true, true>(L, g, S, E);
        }
#endif
        SEAM(pb0 + 2);
#ifndef SKIP_G4
        if (IN(pb0 + 3)) {
            pg8::Gemm g{XB, (const bf16*)((const unsigned char*)wb + W_G) + (size_t)i * 1024 * 1024, T, D, D, D, D}; pg8::StaticOrder S; S.init(T, D, G, bx);
            pg8::EpiResid<true> E{nullptr, XB, PP, PP, ss_mid, ss_out};
            pg8::gemm_phase<pg8::EpiResid<true>, pg8::StaticOrder, true, true>(L, g, S, E);
        }
#endif
        SEAM(pb0 + 3);
    }
    if (IN(N_PHASES - 1)) final_norm((const bf16*)(ws + WS_U), args.out, (const float*)(ws + WS_SS + (size_t)8 * SS_STAGE), args.in[13], vcu, G, wave);
#undef IN
#undef SEAM
}

extern "C" void kernel_launch(void* const* d_in, const int* in_sizes, int n_in, void* d_out, int out_size, void* d_ws, size_t ws_size, hipStream_t stream) {
    static int grid = 0;
    if (grid == 0) {
        if (n_in != 14 || out_size != T * D || ws_size < WS_END) { fprintf(stderr, "kernel_launch: unexpected shapes: n_in %d out %d ws %zu (need %zu)\n", n_in, out_size, ws_size, (size_t)WS_END); grid = -1; return; }
        int dev = 0, cus = 0, per_cu = 0;
        hipGetDevice(&dev); hipDeviceGetAttribute(&cus, hipDeviceAttributeMultiprocessorCount, dev);
        if (hipFuncSetAttribute((const void*)mk_fwd, hipFuncAttributeMaxDynamicSharedMemorySize, LDS_BYTES) != hipSuccess) { fprintf(stderr, "kernel_launch: hipFuncSetAttribute failed\n"); grid = -1; return; }
        if (hipOccupancyMaxActiveBlocksPerMultiprocessor(&per_cu, (const void*)mk_fwd, NWAVES * 64, LDS_BYTES) != hipSuccess || per_cu < 1) { fprintf(stderr, "kernel_launch: occupancy query says %d\n", per_cu); per_cu = 1; }
        (void)hipGetLastError();
        grid = cus;
        fprintf(stderr, "kernel_launch: grid %d (occupancy query %d/CU), ws %zu\n", grid, per_cu, ws_size);
    }
    if (grid < 0) return;
#if MK_PER_PHASE
    if (hipMemsetAsync((char*)d_ws + WS_BAR, 0, BAR_ZERO_BYTES, stream) != hipSuccess) { fprintf(stderr, "kernel_launch: memset failed\n"); return; }
#endif
    Args a{};
    for (int i = 0; i < 14; ++i) a.in[i] = (const float*)d_in[i];
    a.out = (float*)d_out; a.ws = (unsigned char*)d_ws;
#if MK_PER_PHASE
    for (int ph = 0; ph < N_PHASES; ++ph) { a.ph_lo = ph; a.ph_hi = ph + 1; hipLaunchKernelGGL(mk_fwd, dim3(grid), dim3(NWAVES * 64), LDS_BYTES, stream, a); }
#else
    a.ph_lo = 0; a.ph_hi = N_PHASES;
    void* kargs[] = {&a};
    const hipError_t e = hipLaunchCooperativeKernel((const void*)mk_fwd, dim3(grid), dim3(NWAVES * 64), kargs, LDS_BYTES, stream);
    if (e != hipSuccess) fprintf(stderr, "kernel_launch: cooperative launch failed: %s (grid %d)\n", hipGetErrorString(e), grid);
#endif
}
```
